# Optimizing an MI355X kernel written in HIP

```python
import jax, jax.numpy as jnp
from jax import lax
import numpy as np

D_MODEL = 1024
BATCH = 4
SEQ = 4096
DEPTH = 2

EPS = 1e-6
NEG_INF = -1e30
HEAD_DIM = 64
ATT_HEADS = 8
ATT_WIDTH = ATT_HEADS * HEAD_DIM
MOBA_BLOCK = 256
MOBA_TOPK = 3
MOBA_Q_CHUNK = 32
ROPE_THETA = 10000.0
CONV_WIDTH = 256
CONV_GROUPS = 4
CONV_KERNEL = 31
GLA_HEADS = 4
GLA_DK = 64
GLA_DV = 64
GLA_KWIDTH = GLA_HEADS * GLA_DK
GLA_VWIDTH = GLA_HEADS * GLA_DV
GLA_GATE_RANK = 16
GLA_TAU = 16.0
GLA_CHUNK = 64
MIX_WIDTH = ATT_WIDTH + CONV_WIDTH + GLA_VWIDTH
IN_WIDTH = 3 * ATT_WIDTH + 2 * CONV_WIDTH + 2 * GLA_KWIDTH + 2 * GLA_VWIDTH + GLA_GATE_RANK
D_FF = 2816
FFN_RES = 0.5
N_MOD = 9

kernel_name = "hybrid_moba_conv_gla_macaron_adaln"


def _rmsnorm(x, gain):
    x32 = x.astype(jnp.float32)
    y = x32 * lax.rsqrt(jnp.mean(x32 * x32, axis=-1, keepdims=True) + EPS)
    return (y * gain.astype(jnp.float32)).astype(x.dtype)


def _layernorm(x, gain, bias):
    x32 = x.astype(jnp.float32)
    mu = jnp.mean(x32, axis=-1, keepdims=True)
    xc = x32 - mu
    y = xc * lax.rsqrt(jnp.mean(xc * xc, axis=-1, keepdims=True) + EPS)
    return (y * gain.astype(jnp.float32) + bias.astype(jnp.float32)).astype(x.dtype)


def _modulate(h, shift, scale):
    return h * (1 + scale[:, None, :]) + shift[:, None, :]


def _swiglu(h, w_in, w_out):
    a, b = jnp.split(h @ w_in, 2, axis=-1)
    return (jax.nn.silu(a) * b) @ w_out


def _split_heads(t, n_heads):
    bsz, seq, _ = t.shape
    return t.reshape(bsz, seq, n_heads, -1).transpose(0, 2, 1, 3)


def _merge_heads(t):
    bsz, n_h, seq, hd = t.shape
    return t.transpose(0, 2, 1, 3).reshape(bsz, seq, n_h * hd)


def _rope_tables(positions):
    inv_freq = 1.0 / (ROPE_THETA ** (jnp.arange(0, HEAD_DIM, 2, dtype=jnp.float32) / HEAD_DIM))
    ang = positions.astype(jnp.float32)[:, :, None] * inv_freq
    return jnp.cos(ang)[:, None], jnp.sin(ang)[:, None]


def _rope(t, cos, sin):
    t32 = t.astype(jnp.float32)
    t1, t2 = jnp.split(t32, 2, axis=-1)
    return jnp.concatenate([t1 * cos - t2 * sin, t2 * cos + t1 * sin], axis=-1).astype(t.dtype)


def _moba_attention(q, k, v):
    bsz, n_h, seq, hd = q.shape
    n_blk = -(-seq // MOBA_BLOCK)
    pad = n_blk * MOBA_BLOCK - seq
    widths = ((0, 0), (0, 0), (0, pad), (0, 0))
    kb = jnp.pad(k, widths).reshape(bsz, n_h, n_blk, MOBA_BLOCK, hd)
    vb = jnp.pad(v, widths).reshape(bsz, n_h, n_blk, MOBA_BLOCK, hd)
    k_mean = jnp.mean(kb.astype(jnp.float32), axis=3)
    gate = jnp.einsum('bhsd,bhnd->bhsn', q.astype(jnp.float32), k_mean)
    q_blk = jnp.arange(seq) // MOBA_BLOCK
    past = jnp.arange(n_blk)[None, :] < q_blk[:, None]
    gate = jnp.where(past, gate, NEG_INF)
    n_sel = min(MOBA_TOPK, n_blk)
    _, sel = lax.top_k(gate, n_sel)
    sel_ok = sel < q_blk[:, None]
    b_ix = jnp.arange(bsz)[:, None, None, None]
    h_ix = jnp.arange(n_h)[None, :, None, None]
    scale = hd ** -0.5
    qc_len = MOBA_Q_CHUNK

    def one_chunk(ci):
        t0 = ci * qc_len
        blk = t0 // MOBA_BLOCK
        qc = lax.dynamic_slice_in_dim(q, t0, qc_len, axis=2)
        sc = lax.dynamic_slice_in_dim(sel, t0, qc_len, axis=2)
        okc = lax.dynamic_slice_in_dim(sel_ok, t0, qc_len, axis=2)
        k_own = lax.dynamic_index_in_dim(kb, blk, axis=2, keepdims=False)
        v_own = lax.dynamic_index_in_dim(vb, blk, axis=2, keepdims=False)
        k_sel = kb[b_ix, h_ix, sc]
        v_sel = vb[b_ix, h_ix, sc]
        s_own = jnp.einsum('bhqd,bhld->bhql', qc, k_own).astype(jnp.float32) * scale
        q_pos = t0 + jnp.arange(qc_len)
        k_pos = blk * MOBA_BLOCK + jnp.arange(MOBA_BLOCK)
        s_own = jnp.where(k_pos[None, :] <= q_pos[:, None], s_own, NEG_INF)
        s_sel = jnp.einsum('bhqd,bhqnld->bhqnl', qc, k_sel).astype(jnp.float32) * scale
        s_sel = jnp.where(okc[..., None], s_sel, NEG_INF)
        s_all = jnp.concatenate([s_own, s_sel.reshape(bsz, n_h, qc_len, n_sel * MOBA_BLOCK)], axis=-1)
        p = jax.nn.softmax(s_all, axis=-1).astype(v.dtype)
        p_own = p[..., :MOBA_BLOCK]
        p_sel = p[..., MOBA_BLOCK:].reshape(bsz, n_h, qc_len, n_sel, MOBA_BLOCK)
        return (jnp.einsum('bhql,bhld->bhqd', p_own, v_own)
                + jnp.einsum('bhqnl,bhqnld->bhqd', p_sel, v_sel))

    out = lax.map(one_chunk, jnp.arange(seq // qc_len))
    return out.transpose(1, 2, 0, 3, 4).reshape(bsz, n_h, seq, hd)


def _conformer_conv(u, w_dw, b_dw, gain, bias):
    a, g = jnp.split(u, 2, axis=-1)
    h = a * jax.nn.sigmoid(g)
    h = lax.conv_general_dilated(h, w_dw[:, None, :], (1,), [(CONV_KERNEL - 1, 0)],
                                 dimension_numbers=('NWC', 'WIO', 'NWC'),
                                 feature_group_count=CONV_WIDTH) + b_dw
    bsz, seq, ch = h.shape
    hg = h.reshape(bsz, seq, CONV_GROUPS, ch // CONV_GROUPS)
    hg = _layernorm(hg, gain.reshape(CONV_GROUPS, -1), bias.reshape(CONV_GROUPS, -1))
    return jax.nn.silu(hg.reshape(bsz, seq, ch))


def _gla(q, k, v, g):
    bsz, n_h, seq, dk = q.shape
    dv = v.shape[-1]
    L = GLA_CHUNK
    n_c = seq // L
    f32 = jnp.float32
    qc = (q.astype(f32) * dk ** -0.5).reshape(bsz, n_h, n_c, L, dk)
    kc = k.astype(f32).reshape(bsz, n_h, n_c, L, dk)
    vc = v.astype(f32).reshape(bsz, n_h, n_c, L, dv)
    G = lax.cumsum(g.astype(f32).reshape(bsz, n_h, n_c, L, dk), axis=3)
    q_t = qc * jnp.exp(G)
    k_t = kc * jnp.exp(-G)
    causal = jnp.tril(jnp.ones((L, L), dtype=bool))
    A = jnp.where(causal, jnp.einsum('bhnld,bhnmd->bhnlm', q_t, k_t), 0.0)
    o_intra = jnp.einsum('bhnlm,bhnmv->bhnlv', A, vc)
    G_last = G[:, :, :, -1]
    k_end = kc * jnp.exp(G_last[:, :, :, None, :] - G)
    kv = jnp.einsum('bhnld,bhnlv->bhndv', k_end, vc)

    def step(state, inp):
        decay, kv_n = inp
        return decay[..., None] * state + kv_n, state

    init = jnp.zeros((bsz, n_h, dk, dv), f32)
    _, s_prev = lax.scan(step, init, (jnp.moveaxis(jnp.exp(G_last), 2, 0), jnp.moveaxis(kv, 2, 0)))
    s_prev = jnp.moveaxis(s_prev, 0, 2)
    o_inter = jnp.einsum('bhnld,bhndv->bhnlv', q_t, s_prev)
    return (o_intra + o_inter).reshape(bsz, n_h, seq, dv).astype(v.dtype)


def setup_inputs(seed: int = 0) -> dict:
    key = jax.random.key(seed)
    ks = jax.random.split(key, 24)
    f32 = jnp.float32

    def nrm(k, shape, s):
        return jax.random.normal(k, shape, f32) * s

    def gain(k, shape):
        return 1.0 + 0.05 * jax.random.normal(k, shape, f32)

    offset = jax.random.randint(ks[2], (BATCH, 1), 0, 1024, dtype=jnp.int32)
    positions = (offset + jnp.arange(SEQ, dtype=jnp.int32)[None, :]).astype(jnp.int32)
    return {
        "x": nrm(ks[0], (BATCH, SEQ, D_MODEL), 1.0),
        "c": nrm(ks[1], (BATCH, D_MODEL), 1.0),
        "positions": positions,
        "ada_w": nrm(ks[3], (DEPTH, D_MODEL, N_MOD * D_MODEL), 0.5 * D_MODEL ** -0.5),
        "ada_b": nrm(ks[4], (DEPTH, N_MOD * D_MODEL), 0.02),
        "ffn1_norm": gain(ks[5], (DEPTH, D_MODEL)),
        "ffn1_w_in": nrm(ks[6], (DEPTH, D_MODEL, 2 * D_FF), D_MODEL ** -0.5),
        "ffn1_w_out": nrm(ks[7], (DEPTH, D_FF, D_MODEL), D_FF ** -0.5),
        "mix_norm": gain(ks[8], (DEPTH, D_MODEL)),
        "mix_w_in": nrm(ks[9], (DEPTH, D_MODEL, IN_WIDTH), D_MODEL ** -0.5),
        "q_norm": gain(ks[10], (DEPTH, HEAD_DIM)),
        "k_norm": gain(ks[11], (DEPTH, HEAD_DIM)),
        "conv_w": nrm(ks[12], (DEPTH, CONV_KERNEL, CONV_WIDTH), CONV_KERNEL ** -0.5),
        "conv_b": nrm(ks[13], (DEPTH, CONV_WIDTH), 0.02),
        "conv_norm_g": gain(ks[14], (DEPTH, CONV_WIDTH)),
        "conv_norm_b": nrm(ks[15], (DEPTH, CONV_WIDTH), 0.02),
        "gla_gate_w": nrm(ks[16], (DEPTH, GLA_GATE_RANK, GLA_KWIDTH), GLA_GATE_RANK ** -0.5),
        "gla_gate_b": nrm(ks[17], (DEPTH, GLA_KWIDTH), 0.1),
        "gla_out_norm": gain(ks[18], (DEPTH, GLA_DV)),
        "mix_w_out": nrm(ks[19], (DEPTH, MIX_WIDTH, D_MODEL), MIX_WIDTH ** -0.5),
        "ffn2_norm": gain(ks[20], (DEPTH, D_MODEL)),
        "ffn2_w_in": nrm(ks[21], (DEPTH, D_MODEL, 2 * D_FF), D_MODEL ** -0.5),
        "ffn2_w_out": nrm(ks[22], (DEPTH, D_FF, D_MODEL), D_FF ** -0.5),
    }


def reference(x, c, positions, ada_w, ada_b, ffn1_norm, ffn1_w_in, ffn1_w_out, mix_norm, mix_w_in,
              q_norm, k_norm, conv_w, conv_b, conv_norm_g, conv_norm_b, gla_gate_w, gla_gate_b,
              gla_out_norm, mix_w_out, ffn2_norm, ffn2_w_in, ffn2_w_out):
    cos, sin = _rope_tables(positions)
    c_act = jax.nn.silu(c)
    splits = list(np.cumsum([ATT_WIDTH, ATT_WIDTH, ATT_WIDTH, 2 * CONV_WIDTH,
                             GLA_KWIDTH, GLA_KWIDTH, GLA_VWIDTH, GLA_VWIDTH]))
    for l in range(DEPTH):
        mod = c_act @ ada_w[l] + ada_b[l]
        sh1, sc1, gt1, sh2, sc2, gt2, sh3, sc3, gt3 = jnp.split(mod, N_MOD, axis=-1)

        h = _modulate(_rmsnorm(x, ffn1_norm[l]), sh1, sc1)
        x = x + FFN_RES * gt1[:, None, :] * _swiglu(h, ffn1_w_in[l], ffn1_w_out[l])

        h = _modulate(_rmsnorm(x, mix_norm[l]), sh2, sc2)
        proj = h @ mix_w_in[l]
        a_q, a_k, a_v, b_u, c_q, c_k, c_v, c_r, c_g = jnp.split(proj, splits, axis=-1)

        qa = _rope(_rmsnorm(_split_heads(a_q, ATT_HEADS), q_norm[l]), cos, sin)
        ka = _rope(_rmsnorm(_split_heads(a_k, ATT_HEADS), k_norm[l]), cos, sin)
        va = _split_heads(a_v, ATT_HEADS)
        o_a = _merge_heads(_moba_attention(qa, ka, va))

        o_b = _conformer_conv(b_u, conv_w[l], conv_b[l], conv_norm_g[l], conv_norm_b[l])

        log_decay = jax.nn.log_sigmoid(c_g @ gla_gate_w[l] + gla_gate_b[l]) / GLA_TAU
        o_c = _gla(_split_heads(c_q, GLA_HEADS), _split_heads(c_k, GLA_HEADS),
                   _split_heads(c_v, GLA_HEADS), _split_heads(log_decay, GLA_HEADS))
        o_c = _merge_heads(_rmsnorm(o_c, gla_out_norm[l])) * jax.nn.silu(c_r)

        mixed = jnp.concatenate([o_a, o_b, o_c], axis=-1) @ mix_w_out[l]
        x = x + gt2[:, None, :] * mixed

        h = _modulate(_rmsnorm(x, ffn2_norm[l]), sh3, sc3)
        x = x + FFN_RES * gt3[:, None, :] * _swiglu(h, ffn2_w_in[l], ffn2_w_out[l])
    return x
```

```cpp
#include <hip/hip_runtime.h>
#include <cstdio>
#include <cstdint>
#include <cmath>
#include <hip/hip_bf16.h>
#include <hip/hip_cooperative_groups.h>
namespace {
constexpr int D = 1024, NB = 4, S = 4096, M = NB * S, DEPTH = 2;
constexpr int DFF = 2816, INW = 3088, NMOD = 9, MODW = NMOD * D;
constexpr int OFF_Q = 0, OFF_K = 512, OFF_V = 1024, OFF_BU = 1536, OFF_CQ = 2048, OFF_CK = 2304, OFF_CV = 2560, OFF_CR = 2816, OFF_CG = 3072;
constexpr float EPS = 1e-6f;
constexpr float QSCALE = 0.125f * 1.4426950408889634f;
constexpr int NWAVES = 8, NTHREADS = 512, GRID = 256;
constexpr int LDS_BYTES = 147456;

constexpr size_t MiB = 1u << 20;
constexpr size_t WS_CTL = 0, CTL_ZERO_BYTES = 1 * MiB;
constexpr size_t WS_MOD = 1 * MiB;
constexpr size_t WS_GP = 1 * MiB + 512 * 1024;
constexpr size_t WS_SW = 2 * MiB;
constexpr int SW_F1 = 0, SW_MIX = 4 * 5632, SW_CG = SW_MIX + 4 * 3072, SW_F2 = SW_CG + 64, SWL = SW_F2 + 4 * 5632;
constexpr size_t WS_ROWSS = 3 * MiB;
constexpr size_t WS_KMEAN = 3 * MiB + 512 * 1024;
constexpr size_t WS_ROPEC = 4 * MiB, WS_ROPES = 6 * MiB;
constexpr size_t WS_CG = 8 * MiB;
constexpr size_t WS_DEC = 9 * MiB;
constexpr size_t WS_WCG = 10 * MiB;
constexpr size_t WS_W = 16 * MiB, W_LAYER = 41 * MiB;
constexpr size_t W_F1IN = 0, W_F1OUT = 11 * MiB, W_MIXIN = 16 * MiB + 512 * 1024, W_MIXOUT = 22 * MiB + 512 * 1024, W_F2IN = 24 * MiB + 512 * 1024, W_F2OUT = 35 * MiB + 512 * 1024;
constexpr size_t WS_XS = 100 * MiB;
constexpr size_t WS_HMID = 132 * MiB;
constexpr size_t WS_QB = 132 * MiB, WS_KB = 148 * MiB, WS_VB = 164 * MiB, WS_HGLU = 180 * MiB, WS_CQ = 188 * MiB, WS_CK = 196 * MiB, WS_CV = 204 * MiB, WS_CR = 212 * MiB;
constexpr size_t WS_CONCAT = 220 * MiB;
constexpr size_t WS_KV = 252 * MiB;
constexpr size_t WS_SPT = 268 * MiB;
constexpr size_t WS_END = 276 * MiB;


template <int K> __device__ __forceinline__ float sx(float v) { return __builtin_bit_cast(float, __builtin_amdgcn_ds_swizzle(__builtin_bit_cast(int, v), (K << 10) | 0x1f)); }
__device__ __forceinline__ float add_x32(float v) { const unsigned u = __builtin_bit_cast(unsigned, v); auto r = __builtin_amdgcn_permlane32_swap(u, u, false, false); return __builtin_bit_cast(float, (unsigned)r[0]) + __builtin_bit_cast(float, (unsigned)r[1]); }
}
namespace pg8 {
#define PG8_LAS __attribute__((address_space(3)))
typedef unsigned short bf16_t;
typedef short bf16x8 __attribute__((ext_vector_type(8)));
typedef float f32x4 __attribute__((ext_vector_type(4)));
typedef unsigned u32x4 __attribute__((ext_vector_type(4)));
constexpr int BM = 256, BK = 64, HALF = 128, HTB = HALF * BK * 2  , STAGE_BYTES = 8 * HTB, NXCD = 8, WGM = 8;

__host__ __device__ __forceinline__ int lds_byte(int r, int c) { const int st = (r >> 4) * 2 + (c >> 5), rr = r & 15, cc = c & 31, ob = rr * 64 + cc * 2; return st * 1024 + (ob ^ (((ob >> 9) & 1) << 5)); }
__host__ __device__ __forceinline__ void stage_rc(int b, int& R, int& C) { const int st = b / 1024, sb = b % 1024, swz = sb ^ (((sb >> 9) & 1) << 5); R = (st >> 1) * 16 + swz / 64; C = (st & 1) * 32 + (swz % 64) / 2; }
__host__ __device__ __forceinline__ int perm32(int rho) { const int n = rho >> 4, i = rho & 15; return 8 * (i >> 2) + 4 * n + (i & 3); }

struct Unit { int pm, pn; };
struct Gemm { const bf16_t* A; const bf16_t* Bt; int M, N, K; };

struct StaticOrder {
    int nM, nN, nwg, G, c;
    __host__ __device__ void init(int M, int N, int G_, int c_) { nM = M / BM; nN = N / BM; nwg = nM * nN; G = G_; c = c_; }
    __host__ __device__ bool next(int i, Unit& u) const {
        const long L = (long)i * G + c; if (L >= nwg) return false;
        int wgid = (int)L; { const int q = nwg / NXCD, r = nwg % NXCD, xcd = wgid % NXCD, off = wgid / NXCD; wgid = (xcd < r ? xcd * (q + 1) : r * (q + 1) + (xcd - r) * q) + off; }
        const int nig = WGM * nN, gid = wgid / nig, fm = gid * WGM, gsz = (nM - fm) < WGM ? (nM - fm) : WGM;
        u.pm = fm + ((wgid % nig) % gsz); u.pn = (wgid % nig) / gsz; return true;
    }
    __device__ __forceinline__ void a_ready(const Unit&) const {}
    __device__ __forceinline__ void done(const Unit&) const {}
};

__device__ __forceinline__ unsigned cvt_pk_bf16(float lo, float hi) { unsigned r; asm volatile("v_cvt_pk_bf16_f32 %0, %1, %2" : "=v"(r) : "v"(lo), "v"(hi)); return r; }

typedef unsigned u32x2 __attribute__((ext_vector_type(2)));
constexpr float EPI_EPS = 1e-6f;
__device__ __forceinline__ float sigmoid_fast(float v) { return __builtin_amdgcn_rcpf(1.f + __builtin_amdgcn_exp2f(-1.4426950408889634f * v)); }
__device__ __forceinline__ u32x4 pack8(const f32x4 a, const f32x4 b) { u32x4 w; w.x = cvt_pk_bf16(a[0], a[1]); w.y = cvt_pk_bf16(a[2], a[3]); w.z = cvt_pk_bf16(b[0], b[1]); w.w = cvt_pk_bf16(b[2], b[3]); return w; }

struct EpiSwiGLU {
    static constexpr bool PERM = true, AFTER_DRAIN = false;
    unsigned char* ws; int st, swoff;
    __device__ __forceinline__ void operator()(const f32x4 (&acc)[2][2][4][2], const Unit& u, int wr, int wc, int fr_in, int fq_in) const {
        int fr = fr_in, fq = fq_in; asm volatile("" : "+v"(fr), "+v"(fq));
        const int b = u.pm >> 4; constexpr int nbt = 5632, ldh = 2816;
        bf16_t* H = (bf16_t*)(ws + WS_HMID); const float* rowss = (const float*)(ws + WS_ROWSS) + (size_t)st * 16384;
        const float* sw = (const float*)(ws + WS_SW) + swoff + (size_t)b * nbt + u.pn * BM + wc * 32 + 8 * fq;
        const f32x4 sa0 = *(const f32x4*)sw, sa1 = *(const f32x4*)(sw + 4), sb0 = *(const f32x4*)(sw + HALF), sb1 = *(const f32x4*)(sw + HALF + 4);
        const int colh = u.pn * HALF + wc * 32 + 8 * fq;
#pragma unroll
        for (int ai = 0; ai < 2; ++ai)
#pragma unroll
            for (int m = 0; m < 4; ++m) {
                const int row = u.pm * BM + ai * HALF + wr * 64 + m * 16 + fr;
                const float r = __builtin_amdgcn_rsqf(rowss[row] * (1.0f / 1024.0f) + EPI_EPS);
                f32x4 a0 = acc[ai][0][m][0] * r + sa0, a1 = acc[ai][0][m][1] * r + sa1, b0 = acc[ai][1][m][0] * r + sb0, b1 = acc[ai][1][m][1] * r + sb1;
                f32x4 o0, o1;
#pragma unroll
                for (int j = 0; j < 4; ++j) { o0[j] = a0[j] * sigmoid_fast(a0[j]) * b0[j]; o1[j] = a1[j] * sigmoid_fast(a1[j]) * b1[j]; }
                *(u32x4*)(H + (size_t)row * ldh + colh) = pack8(o0, o1);
            }
    }
};

struct EpiResid {
    static constexpr bool PERM = true, AFTER_DRAIN = false;
    const float* xin; float* xout; unsigned char* ws; int gate_off; float coef; int nst;
    __device__ __forceinline__ void operator()(const f32x4 (&acc)[2][2][4][2], const Unit& u, int wr, int wc, int fr_in, int fq_in) const {
        int fr = fr_in, fq = fq_in; asm volatile("" : "+v"(fr), "+v"(fq));
        const int b = u.pm >> 4, col0 = u.pn * BM + wc * 32 + 8 * fq;
        const float* gate = (const float*)(ws + WS_MOD) + gate_off; const bool has_next = nst >= 0;
        const float* gp = (const float*)(ws + WS_GP) + (size_t)(has_next ? nst : 0) * 4096; float* rowss_next = (float*)(ws + WS_ROWSS) + (size_t)(has_next ? nst : 0) * 16384;
        bf16_t* XS = (bf16_t*)(ws + WS_XS); const f32x4 cv = {coef, coef, coef, coef};
        f32x4 g[2][2], p[2][2];
#pragma unroll
        for (int bj = 0; bj < 2; ++bj)
#pragma unroll
            for (int n = 0; n < 2; ++n) { g[bj][n] = *(const f32x4*)(gate + (size_t)b * 9216 + col0 + bj * HALF + 4 * n) * cv;
                p[bj][n] = *(const f32x4*)(gp + (size_t)b * 1024 + col0 + bj * HALF + 4 * n); }
#pragma unroll
        for (int ai = 0; ai < 2; ++ai)
#pragma unroll
            for (int m = 0; m < 4; ++m) {
                const int row = u.pm * BM + ai * HALF + wr * 64 + m * 16 + fr;
                const size_t off = (size_t)row * 1024 + col0;
                float ssq = 0.f;
#pragma unroll
                for (int bj = 0; bj < 2; ++bj) {
                    f32x4 xn[2];
#pragma unroll
                    for (int n = 0; n < 2; ++n) { const f32x4 x = *(const f32x4*)(xin + off + bj * HALF + 4 * n); xn[n] = x + g[bj][n] * acc[ai][bj][m][n];
                        *(f32x4*)(xout + off + bj * HALF + 4 * n) = xn[n]; ssq += (xn[n][0] * xn[n][0] + xn[n][1] * xn[n][1]) + (xn[n][2] * xn[n][2] + xn[n][3] * xn[n][3]); }
                    if (has_next) *(u32x4*)(XS + off + bj * HALF) = pack8(xn[0] * p[bj][0], xn[1] * p[bj][1]);
                }
                if (has_next) { ssq += sx<16>(ssq); ssq = add_x32(ssq); if (fq == 0) atomicAdd(rowss_next + row, ssq); }
                asm volatile("" ::: "memory");
            }
    }
};

struct EpiMixIn {
    static constexpr bool PERM = true, AFTER_DRAIN = false;
    unsigned char* ws; const float *qn, *kn; int l; float qscale;
    __device__ __forceinline__ void operator()(const f32x4 (&acc)[2][2][4][2], const Unit& u, int wr, int wc, int fr_in, int fq_in) const {
        int fr = fr_in, fq = fq_in; asm volatile("" : "+v"(fr), "+v"(fq));
        const int b = u.pm >> 4, blk = u.pm & 15, pn = u.pn;
        const float* rowss = (const float*)(ws + WS_ROWSS) + (size_t)(3 * l + 1) * 16384;
        const float* sw = (const float*)(ws + WS_SW) + (size_t)l * SWL + SW_MIX + (size_t)b * 3072 + pn * BM + wc * 32 + 8 * fq;
        f32x4 s[2][2];
#pragma unroll
        for (int bj = 0; bj < 2; ++bj)
#pragma unroll
            for (int n = 0; n < 2; ++n) s[bj][n] = *(const f32x4*)(sw + bj * HALF + 4 * n);
        if (pn < 4) {
            const bool isk = pn >= 2; const int head = 4 * (pn & 1) + wc;
            const float* gn = isk ? kn : qn;
            f32x4 gl[2], gh[2], ks[2][2];
#pragma unroll
            for (int n = 0; n < 2; ++n) { gl[n] = *(const f32x4*)(gn + 8 * fq + 4 * n); gh[n] = *(const f32x4*)(gn + 32 + 8 * fq + 4 * n); ks[0][n] = (f32x4){0.f, 0.f, 0.f, 0.f}; ks[1][n] = (f32x4){0.f, 0.f, 0.f, 0.f}; }
            bf16_t* dstb = (bf16_t*)(ws + (isk ? WS_KB : WS_QB)) + head * 64 + 8 * fq;
            const float* ropec = (const float*)(ws + WS_ROPEC); const float* ropes = (const float*)(ws + WS_ROPES);
            const float osc = isk ? 1.0f : qscale;
#pragma unroll
            for (int ai = 0; ai < 2; ++ai)
#pragma unroll
                for (int m = 0; m < 4; ++m) {
                    const int row = u.pm * BM + ai * HALF + wr * 64 + m * 16 + fr;
                    const float r = __builtin_amdgcn_rsqf(rowss[row] * (1.0f / 1024.0f) + EPI_EPS);
                    f32x4 v[2][2]; float ss = 0.f;
#pragma unroll
                    for (int bj = 0; bj < 2; ++bj)
#pragma unroll
                        for (int n = 0; n < 2; ++n) { v[bj][n] = acc[ai][bj][m][n] * r + s[bj][n]; ss += (v[bj][n][0] * v[bj][n][0] + v[bj][n][1] * v[bj][n][1]) + (v[bj][n][2] * v[bj][n][2] + v[bj][n][3] * v[bj][n][3]); }
                    ss += sx<16>(ss); ss = add_x32(ss);
                    const float rn = __builtin_amdgcn_rsqf(ss * (1.0f / 64.0f) + EPI_EPS);
                    f32x4 ol[2], oh[2];
#pragma unroll
                    for (int n = 0; n < 2; ++n) { const f32x4 cs = *(const f32x4*)(ropec + (size_t)row * 32 + 8 * fq + 4 * n), sn = *(const f32x4*)(ropes + (size_t)row * 32 + 8 * fq + 4 * n);
                        const f32x4 yl = v[0][n] * rn * gl[n], yh = v[1][n] * rn * gh[n];
                        ol[n] = (yl * cs - yh * sn) * osc; oh[n] = (yh * cs + yl * sn) * osc;
                        ks[0][n] += ol[n]; ks[1][n] += oh[n]; }
                    *(u32x4*)(dstb + (size_t)row * 512) = pack8(ol[0], ol[1]);
                    *(u32x4*)(dstb + (size_t)row * 512 + 32) = pack8(oh[0], oh[1]);
                    asm volatile("" ::: "memory");
                }
            if (isk) {
                float* km = (float*)(ws + WS_KMEAN) + (size_t)l * 32768 + ((size_t)(b * 8 + head) * 16 + blk) * 64 + 8 * fq;
#pragma unroll
                for (int bj = 0; bj < 2; ++bj)
#pragma unroll
                    for (int n = 0; n < 2; ++n)
#pragma unroll
                        for (int j = 0; j < 4; ++j) { float t = ks[bj][n][j]; t += sx<1>(t); t += sx<2>(t); t += sx<4>(t); t += sx<8>(t);
                            if (fr == 0) atomicAdd(km + 32 * bj + 4 * n + j, t * (1.0f / 256.0f)); }
            }
        } else if (pn == 6 || pn == 7) {
            const int colg = (pn - 6) * HALF + wc * 32 + 8 * fq;
#pragma unroll
            for (int ai = 0; ai < 2; ++ai)
#pragma unroll
                for (int m = 0; m < 4; ++m) {
                    const int row = u.pm * BM + ai * HALF + wr * 64 + m * 16 + fr;
                    const float r = __builtin_amdgcn_rsqf(rowss[row] * (1.0f / 1024.0f) + EPI_EPS);
                    f32x4 o[2];
#pragma unroll
                    for (int n = 0; n < 2; ++n) { const f32x4 a = acc[ai][0][m][n] * r + s[0][n], g = acc[ai][1][m][n] * r + s[1][n];
#pragma unroll
                        for (int j = 0; j < 4; ++j) o[n][j] = a[j] * sigmoid_fast(g[j]); }
                    *(u32x4*)((bf16_t*)(ws + WS_HGLU) + (size_t)row * 256 + colg) = pack8(o[0], o[1]);
                }
        } else {
            bf16_t* dst; int ld;
            if (pn < 6) { dst = (bf16_t*)(ws + WS_VB) + (pn - 4) * BM; ld = 512; } else { dst = (bf16_t*)(ws + WS_CQ + (size_t)(pn - 8) * (8u << 20)); ld = 256; }
            dst += wc * 32 + 8 * fq;
#pragma unroll
            for (int ai = 0; ai < 2; ++ai)
#pragma unroll
                for (int m = 0; m < 4; ++m) {
                    const int row = u.pm * BM + ai * HALF + wr * 64 + m * 16 + fr;
                    const float r = __builtin_amdgcn_rsqf(rowss[row] * (1.0f / 1024.0f) + EPI_EPS);
#pragma unroll
                    for (int bj = 0; bj < 2; ++bj) *(u32x4*)(dst + (size_t)row * ld + bj * HALF) = pack8(acc[ai][bj][m][0] * r + s[bj][0], acc[ai][bj][m][1] * r + s[bj][1]);
                }
        }
    }
};


template <class Epi, class Sched, bool ALIGN_EPI = false, bool SP2 = false>
__device__ __forceinline__ void gemm_phase(PG8_LAS unsigned char* lds, const Gemm g, const Sched& S, const Epi& E, const int tid_in) {
    const int tid = tid_in, wid = __builtin_amdgcn_readfirstlane(tid >> 6), lane = tid & 63, wr = wid >> 2, wc = wid & 3, fr = lane & 15, fq = lane >> 4;
    const int K = g.K, nt = K / BK;
    unsigned voffA[2], voffB[2];
#pragma unroll
    for (int i = 0; i < 2; ++i) { int R, C; stage_rc(tid * 16 + i * 8192, R, C); const int Rb = Epi::PERM ? ((R & ~31) + perm32(R & 31)) : R;
        voffA[i] = (unsigned)(R * K + C) * 2u; voffB[i] = (unsigned)(Rb * K + C) * 2u; }
    const size_t kstep = (size_t)(BK * 2);
    const size_t hstep = (size_t)HALF * K * 2;
    const size_t tstep = 2 * hstep;
    const unsigned ldsw = (unsigned)wid * 1024u;
    const int aoff = lds_byte(wr * 64 + fr, fq * 8), boff = lds_byte(wc * 32 + fr, fq * 8);
#define PG8_SA(b, h) (((b) * 2 + (h)) * HTB)
#define PG8_SB(b, h) ((4 + (b) * 2 + (h)) * HTB)
#define PG8_STAGE(bufoff, gbase, voff) do { _Pragma("unroll") for (int _i = 0; _i < 2; ++_i) \
        __builtin_amdgcn_global_load_lds((const unsigned*)((const char*)(gbase) + (voff)[_i]), (PG8_LAS unsigned*)(lds + (bufoff) + ldsw + _i * 8192), 16, 0, 0); } while (0)
#define PG8_LDA(dst, b, h) do { _Pragma("unroll") for (int m = 0; m < 4; ++m) _Pragma("unroll") for (int k = 0; k < 2; ++k) dst[m][k] = *(const PG8_LAS bf16x8*)(lds + PG8_SA(b, h) + aoff + m * 2048 + k * 1024); } while (0)
#define PG8_LDB(dst, b, h) do { _Pragma("unroll") for (int n = 0; n < 2; ++n) _Pragma("unroll") for (int k = 0; k < 2; ++k) dst[n][k] = *(const PG8_LAS bf16x8*)(lds + PG8_SB(b, h) + boff + n * 2048 + k * 1024); } while (0)
#define PG8_MMA(ai, bj, At, Bt) do { __builtin_amdgcn_s_setprio(1); _Pragma("unroll") for (int m = 0; m < 4; ++m) _Pragma("unroll") for (int n = 0; n < 2; ++n) _Pragma("unroll") for (int k = 0; k < 2; ++k) \
        acc[ai][bj][m][n] = __builtin_amdgcn_mfma_f32_16x16x32_bf16(Bt[n][k], At[m][k], acc[ai][bj][m][n], 0, 0, 0); __builtin_amdgcn_s_setprio(0); } while (0)
#define PG8_WAIT_V(n) asm volatile("s_waitcnt vmcnt(" #n ")" ::: "memory")
#define PG8_WAIT_L(n) asm volatile("s_waitcnt lgkmcnt(" #n ")" ::: "memory")
#define PG8_BAR __builtin_amdgcn_s_barrier()
#define PG8_SCHED __builtin_amdgcn_sched_barrier(0)
    Unit cur, nxt; int ui = 0;
    if (!S.next(0, cur)) return;
    f32x4 acc[2][2][4][2];
#pragma unroll
    for (int a = 0; a < 2; ++a)
#pragma unroll
        for (int b = 0; b < 2; ++b)
#pragma unroll
            for (int m = 0; m < 4; ++m)
#pragma unroll
                for (int n = 0; n < 2; ++n) acc[a][b][m][n] = (f32x4){0.f, 0.f, 0.f, 0.f};
    bf16x8 At[4][2], B0[2][2], B1[2][2];
    const char* cA = (const char*)g.A + (size_t)cur.pm * tstep; const char* cB = (const char*)g.Bt + (size_t)cur.pn * tstep;
    S.a_ready(cur);
    if constexpr (SP2) {
        PG8_STAGE(PG8_SB(0, 0), cB, voffB); PG8_STAGE(PG8_SB(0, 1), cB + hstep, voffB); PG8_STAGE(PG8_SA(0, 0), cA, voffA); PG8_STAGE(PG8_SA(0, 1), cA + hstep, voffA);
        if (wr == 1) PG8_BAR;
        PG8_WAIT_V(2); PG8_BAR;
        PG8_STAGE(PG8_SB(1, 0), cB + kstep, voffB); PG8_STAGE(PG8_SA(1, 0), cA + kstep, voffA); PG8_STAGE(PG8_SB(1, 1), cB + hstep + kstep, voffB);
        PG8_WAIT_V(6); PG8_BAR;
    } else {
        PG8_STAGE(PG8_SB(0, 0), cB, voffB); PG8_STAGE(PG8_SA(0, 0), cA, voffA); PG8_STAGE(PG8_SB(0, 1), cB + hstep, voffB); PG8_STAGE(PG8_SA(0, 1), cA + hstep, voffA);
        if (wr == 1) PG8_BAR;
        PG8_WAIT_V(4); PG8_BAR;
        PG8_STAGE(PG8_SB(1, 0), cB + kstep, voffB); PG8_STAGE(PG8_SA(1, 0), cA + kstep, voffA); PG8_STAGE(PG8_SB(1, 1), cB + hstep + kstep, voffB);
        PG8_WAIT_V(6); PG8_BAR;
    }
    for (;;) {
        const bool has_next = S.next(ui + 1, nxt);
        const char* nA = has_next ? (const char*)g.A + (size_t)nxt.pm * tstep : cA; const char* nB = has_next ? (const char*)g.Bt + (size_t)nxt.pn * tstep : cB;
        for (int t = 0; t < nt; t += 2) {
            const bool last = (t == nt - 2);
            const char* a1 = cA + (size_t)(t + 1) * kstep;
            const char* a2 = last ? nA : cA + (size_t)(t + 2) * kstep; const char* b2 = last ? nB : cB + (size_t)(t + 2) * kstep;
            const char* a3 = a2 + kstep; const char* b3 = b2 + kstep;
            if (last && has_next) S.a_ready(nxt);
            if constexpr (SP2) {
            PG8_LDB(B0, 0, 0); PG8_LDB(B1, 0, 1); PG8_SCHED; PG8_LDA(At, 0, 0); PG8_STAGE(PG8_SA(1, 1), a1 + hstep, voffA);
            PG8_WAIT_V(8); PG8_WAIT_L(0); PG8_BAR; PG8_MMA(0, 0, At, B0); PG8_MMA(0, 1, At, B1); PG8_BAR; PG8_SCHED;
            PG8_LDA(At, 0, 1); PG8_STAGE(PG8_SB(0, 0), b2, voffB); PG8_STAGE(PG8_SB(0, 1), b2 + hstep, voffB); PG8_STAGE(PG8_SA(0, 0), a2, voffA);
            PG8_WAIT_V(8); PG8_WAIT_L(0); PG8_BAR; PG8_MMA(1, 0, At, B0); PG8_MMA(1, 1, At, B1); PG8_BAR; PG8_SCHED;
            PG8_LDB(B0, 1, 0); PG8_LDB(B1, 1, 1); PG8_SCHED; PG8_LDA(At, 1, 0); PG8_STAGE(PG8_SA(0, 1), a2 + hstep, voffA);
            PG8_WAIT_V(8); PG8_WAIT_L(0); PG8_BAR; PG8_MMA(0, 0, At, B0); PG8_MMA(0, 1, At, B1); PG8_BAR; PG8_SCHED;
            PG8_LDA(At, 1, 1); PG8_STAGE(PG8_SB(1, 0), b3, voffB); PG8_STAGE(PG8_SB(1, 1), b3 + hstep, voffB); PG8_STAGE(PG8_SA(1, 0), a3, voffA);
            PG8_WAIT_V(8); PG8_WAIT_L(0); PG8_BAR; PG8_MMA(1, 0, At, B0); PG8_MMA(1, 1, At, B1); PG8_BAR; PG8_SCHED;
            } else {
            PG8_LDB(B0, 0, 0); PG8_SCHED; PG8_LDA(At, 0, 0); PG8_STAGE(PG8_SA(1, 1), a1 + hstep, voffA);
            PG8_WAIT_L(8); PG8_BAR; PG8_WAIT_L(0); PG8_MMA(0, 0, At, B0); PG8_BAR; PG8_SCHED;
            PG8_LDB(B1, 0, 1); PG8_STAGE(PG8_SB(0, 0), b2, voffB);
            PG8_BAR; PG8_WAIT_L(0); PG8_MMA(0, 1, At, B1); PG8_BAR;
            PG8_LDA(At, 0, 1); PG8_STAGE(PG8_SA(0, 0), a2, voffA);
            PG8_BAR; PG8_WAIT_L(0); PG8_MMA(1, 0, At, B0); PG8_BAR; PG8_SCHED;
            PG8_STAGE(PG8_SB(0, 1), b2 + hstep, voffB);
            PG8_WAIT_V(6); PG8_BAR; PG8_MMA(1, 1, At, B1); PG8_BAR;
            PG8_LDB(B0, 1, 0); PG8_SCHED; PG8_LDA(At, 1, 0); PG8_STAGE(PG8_SA(0, 1), a2 + hstep, voffA);
            PG8_WAIT_L(8); PG8_BAR; PG8_WAIT_L(0); PG8_MMA(0, 0, At, B0); PG8_BAR; PG8_SCHED;
            PG8_LDB(B1, 1, 1); PG8_STAGE(PG8_SB(1, 0), b3, voffB);
            PG8_BAR; PG8_WAIT_L(0); PG8_MMA(0, 1, At, B1); PG8_BAR;
            PG8_LDA(At, 1, 1); PG8_STAGE(PG8_SA(1, 0), a3, voffA);
            PG8_BAR; PG8_WAIT_L(0); PG8_MMA(1, 0, At, B0); PG8_BAR; PG8_SCHED;
            PG8_STAGE(PG8_SB(1, 1), b3 + hstep, voffB);
            PG8_WAIT_V(6); PG8_BAR; PG8_MMA(1, 1, At, B1); PG8_BAR;
            }
        }
        if constexpr (ALIGN_EPI) { if (wr == 0) PG8_BAR; }
        if constexpr (!Epi::AFTER_DRAIN) { E(acc, cur, wr, wc, fr, fq); S.done(cur); }
        if (!has_next) break;
#pragma unroll
        for (int a = 0; a < 2; ++a)
#pragma unroll
            for (int b = 0; b < 2; ++b)
#pragma unroll
                for (int m = 0; m < 4; ++m)
#pragma unroll
                    for (int n = 0; n < 2; ++n) acc[a][b][m][n] = (f32x4){0.f, 0.f, 0.f, 0.f};
        cur = nxt; cA = nA; cB = nB; ++ui;
        if constexpr (ALIGN_EPI) { if (wr == 1) PG8_BAR; }
    }
    PG8_WAIT_V(0);
    if constexpr (!ALIGN_EPI) { if (wr == 0) PG8_BAR; }
    PG8_BAR;
    if constexpr (Epi::AFTER_DRAIN) { E.fused(acc, cur, wr, wc, fr, fq, lds, wid, lane); S.done(cur); }
#undef PG8_SA
#undef PG8_SB
#undef PG8_STAGE
#undef PG8_LDA
#undef PG8_LDB
#undef PG8_MMA
#undef PG8_WAIT_V
#undef PG8_WAIT_L
#undef PG8_BAR
#undef PG8_SCHED
}
}

namespace {
__constant__ float INV_FREQ[32] = {0x1.000000p+0f, 0x1.7ff222p-1f, 0x1.1feb34p-1f, 0x1.afd136p-2f, 0x1.43d136p-2f, 0x1.e5a84ap-3f, 0x1.6c310ep-3f, 0x1.111aeep-3f,
    0x1.99999ap-4f, 0x1.33281ap-4f, 0x1.ccab84p-5f, 0x1.59742ap-5f, 0x1.030dc6p-5f, 0x1.84869ep-6f, 0x1.235a72p-6f, 0x1.b4f7e4p-7f,
    0x1.47ae14p-7f, 0x1.eb7360p-8f, 0x1.708938p-8f, 0x1.145ceep-8f, 0x1.9e7c70p-9f, 0x1.36d21ap-9f, 0x1.d22a50p-10f, 0x1.5d931cp-10f,
    0x1.0624dep-10f, 0x1.892918p-11f, 0x1.26d42cp-11f, 0x1.ba2e4ep-12f, 0x1.4b96c0p-12f, 0x1.f1502ap-13f, 0x1.74eea6p-13f, 0x1.17a8e4p-13f};

#define LAS __attribute__((address_space(3)))
typedef unsigned short bf16;
typedef unsigned v4u __attribute__((ext_vector_type(4)));
typedef float f32x4 __attribute__((ext_vector_type(4)));
typedef float f32x2 __attribute__((ext_vector_type(2)));
#define LDS_WAIT() asm volatile("s_waitcnt lgkmcnt(0)" ::: "memory")

__device__ __forceinline__ unsigned f2bf(float f) { unsigned u = __builtin_bit_cast(unsigned, f); return (u + 0x7fffu + ((u >> 16) & 1u)) >> 16; }
__device__ __forceinline__ unsigned pk2(float lo, float hi) { return f2bf(lo) | (f2bf(hi) << 16); }
__device__ __forceinline__ float bf2f(bf16 v) { return __builtin_bit_cast(float, (unsigned)v << 16); }
__device__ __forceinline__ float wave_sum(float v) { v += sx<1>(v); v += sx<2>(v); v += sx<4>(v); v += sx<8>(v); v += sx<16>(v); return add_x32(v); }
__device__ __forceinline__ float wave_max(float v) {
#pragma unroll
    for (int o = 1; o < 64; o <<= 1) v = fmaxf(v, __shfl_xor(v, o));
    return v;
}
__device__ __forceinline__ float silu_f(float v) { return v / (1.f + expf(-v)); }
__device__ __forceinline__ float sigmoid_f(float v) { return 1.f / (1.f + expf(-v)); }

struct Args { const void* in[23]; float* out; unsigned char* ws; int ph_lo, ph_hi; };
typedef const __attribute__((address_space(4))) Args* ArgsP;

struct Frame {
    LAS unsigned char* lds;
    int tid, lane, wave, vcu, G;
    unsigned char* ws;
};

__device__ __forceinline__ void tr_item(const float* W, int ldw, int K, int src_c0, bf16* WT, int c0, int k0, LAS float* scr, int lane) {
#pragma unroll 8
    for (int i = 0; i < 32; ++i) { const int kk = 2 * i + (lane >> 5); scr[kk * 33 + (lane & 31)] = W[(size_t)(k0 + kk) * ldw + src_c0 + (lane & 31)]; }
    LDS_WAIT(); asm volatile("" ::: "memory");
    const int c = lane & 7;
#pragma unroll
    for (int j = 0; j < 4; ++j) { const int n = (lane >> 3) + 8 * j; const LAS float* s = scr + (8 * c) * 33 + n;
        v4u o; o.x = pk2(s[0 * 33], s[1 * 33]); o.y = pk2(s[2 * 33], s[3 * 33]); o.z = pk2(s[4 * 33], s[5 * 33]); o.w = pk2(s[6 * 33], s[7 * 33]);
        *(v4u*)(WT + (size_t)(c0 + n) * K + k0 + 8 * c) = o; }
    LDS_WAIT(); asm volatile("" ::: "memory");
}
__device__ __forceinline__ int src_ffn_in(int c0) { return ((c0 >> 7) & 1) * DFF + (c0 >> 8) * 128 + (c0 & 127); }
__device__ __forceinline__ int src_mix_in(int c0) {
    const int pn = c0 >> 8, cl = c0 & 255;
    if (pn < 4) { const int head = 4 * (pn & 1) + ((cl >> 5) & 3), dim = 32 * (cl >> 7) + (cl & 31); return (pn < 2 ? OFF_Q : OFF_K) + 64 * head + dim; }
    if (pn < 6) return OFF_V + (c0 - 1024);
    if (pn < 8) return OFF_BU + (cl >> 7) * 256 + 128 * (pn - 6) + (cl & 127);
    return c0;
}
constexpr int IT_FIN = 16 * 176, IT_FOUT = 44 * 32, IT_MIN = 16 * 96, IT_MOUT = 16 * 32, IT_LAYER = 2 * IT_FIN + 2 * IT_FOUT + IT_MIN + IT_MOUT;

__device__ __forceinline__ void p0a(Frame& F, ArgsP a) {
    const float* cvec = (const float*)a->in[1]; const int* positions = (const int*)a->in[2];
    const float* ada_w = (const float*)a->in[3]; const float* ada_b = (const float*)a->in[4];
    float* MOD = (float*)(F.ws + WS_MOD);
    {
        LAS float* sc = (LAS float*)F.lds;
        LAS float* part = (LAS float*)(F.lds + 16384);
        for (int i = F.tid; i < 4096; i += NTHREADS) sc[i] = silu_f(cvec[i]);
        __syncthreads();
        for (int u = F.vcu; u < 2 * 72; u += GRID) {
            const int l = u / 72, ch = u % 72;
            const float* w = ada_w + (size_t)l * D * MODW + ch * 128 + 2 * F.lane;
            float acc[4][2] = {};
            const int kb = F.wave * 128;
#pragma unroll 8
            for (int k = 0; k < 128; ++k) { const f32x2 wv = *(const f32x2*)(w + (size_t)(kb + k) * MODW);
#pragma unroll
                for (int b = 0; b < 4; ++b) { const float s = sc[b * 1024 + kb + k]; acc[b][0] += s * wv.x; acc[b][1] += s * wv.y; } }
#pragma unroll
            for (int b = 0; b < 4; ++b) { part[(F.wave * 4 + b) * 128 + 2 * F.lane] = acc[b][0]; part[(F.wave * 4 + b) * 128 + 2 * F.lane + 1] = acc[b][1]; }
            __syncthreads();
            { const int b = F.tid >> 7, col = F.tid & 127; float s = 0.f;
#pragma unroll
                for (int w8 = 0; w8 < 8; ++w8) s += part[(w8 * 4 + b) * 128 + col];
                MOD[((size_t)l * NB + b) * MODW + ch * 128 + col] = s + ada_b[(size_t)l * MODW + ch * 128 + col]; }
            __syncthreads();
        }
        __syncthreads();
    }
    {
        LAS float* scr = (LAS float*)(F.lds + F.wave * 16384);
        const int gw = F.vcu * NWAVES + F.wave, NGW = GRID * NWAVES;
        for (int it = gw; it < DEPTH * IT_LAYER; it += NGW) {
            const int l = it / IT_LAYER; int r = it % IT_LAYER;
            unsigned char* wl = F.ws + WS_W + (size_t)l * W_LAYER;
            if (r < IT_FIN) { const int kb = r / 176, cb = r % 176; tr_item((const float*)a->in[6] + (size_t)l * D * 2 * DFF, 2 * DFF, D, src_ffn_in(32 * cb), (bf16*)(wl + W_F1IN), 32 * cb, 64 * kb, scr, F.lane); continue; } r -= IT_FIN;
            if (r < IT_FOUT) { const int kb = r / 32, cb = r % 32; tr_item((const float*)a->in[7] + (size_t)l * DFF * D, D, DFF, 32 * cb, (bf16*)(wl + W_F1OUT), 32 * cb, 64 * kb, scr, F.lane); continue; } r -= IT_FOUT;
            if (r < IT_MIN) { const int kb = r / 96, cb = r % 96; tr_item((const float*)a->in[9] + (size_t)l * D * INW, INW, D, src_mix_in(32 * cb), (bf16*)(wl + W_MIXIN), 32 * cb, 64 * kb, scr, F.lane); continue; } r -= IT_MIN;
            if (r < IT_MOUT) { const int kb = r / 32, cb = r % 32; tr_item((const float*)a->in[19] + (size_t)l * D * D, D, D, 32 * cb, (bf16*)(wl + W_MIXOUT), 32 * cb, 64 * kb, scr, F.lane); continue; } r -= IT_MOUT;
            if (r < IT_FIN) { const int kb = r / 176, cb = r % 176; tr_item((const float*)a->in[21] + (size_t)l * D * 2 * DFF, 2 * DFF, D, src_ffn_in(32 * cb), (bf16*)(wl + W_F2IN), 32 * cb, 64 * kb, scr, F.lane); continue; } r -= IT_FIN;
            { const int kb = r / 32, cb = r % 32; tr_item((const float*)a->in[22] + (size_t)l * DFF * D, D, DFF, 32 * cb, (bf16*)(wl + W_F2OUT), 32 * cb, 64 * kb, scr, F.lane); }
        }
    }
    const int gt = F.vcu * NTHREADS + F.tid, NGT = GRID * NTHREADS;
    { bf16* wcg = (bf16*)(F.ws + WS_WCG);
        for (int i = gt; i < DEPTH * 16 * 1024; i += NGT) { const int l = i >> 14, n = (i >> 10) & 15, k = i & 1023;
            wcg[i] = (bf16)f2bf(((const float*)a->in[9])[(size_t)l * D * INW + (size_t)k * INW + OFF_CG + n]); } }
    { float* rc = (float*)(F.ws + WS_ROPEC); float* rs = (float*)(F.ws + WS_ROPES);
        for (int i = gt; i < M * 32; i += NGT) { const float ang = (float)positions[i >> 5] * INV_FREQ[i & 31]; float sn, cs; sincosf(ang, &sn, &cs); rc[i] = cs; rs[i] = sn; } }
    { float* rss = (float*)(F.ws + WS_ROWSS) + M; for (int i = gt; i < 5 * M; i += NGT) rss[i] = 0.f;
      float* km = (float*)(F.ws + WS_KMEAN); for (int i = gt; i < 2 * 32768; i += NGT) km[i] = 0.f; }
}

__device__ __forceinline__ void p0b(Frame& F, ArgsP a) {
    const float* MOD = (const float*)(F.ws + WS_MOD);
    const int gt = F.vcu * NTHREADS + F.tid, NGT = GRID * NTHREADS;
    { float* GP = (float*)(F.ws + WS_GP);
        for (int i = gt; i < 6 * 4 * 1024; i += NGT) { const int s = i >> 12, b = (i >> 10) & 3, c = i & 1023, l = s / 3, j = s % 3;
            const float* nw = (j == 0 ? (const float*)a->in[5] : (j == 1 ? (const float*)a->in[8] : (const float*)a->in[20])) + l * D;
            GP[i] = nw[c] * (1.f + MOD[((size_t)l * NB + b) * MODW + (1 + 3 * j) * D + c]); } }
    const int gw = F.vcu * NWAVES + F.wave, NGW = GRID * NWAVES;
    for (int l = 0; l < DEPTH; ++l)
        for (int j = 0; j < 3; ++j) {
            float sh[4][16];
#pragma unroll
            for (int b = 0; b < 4; ++b)
#pragma unroll
                for (int q = 0; q < 4; ++q) { const f32x4 t = *(const f32x4*)(MOD + ((size_t)l * NB + b) * MODW + (3 * j) * D + 16 * F.lane + 4 * q); sh[b][4 * q] = t[0]; sh[b][4 * q + 1] = t[1]; sh[b][4 * q + 2] = t[2]; sh[b][4 * q + 3] = t[3]; }
            const int nrows = (j == 1) ? 3072 + 16 : 5632;
            const unsigned char* wl = F.ws + WS_W + (size_t)l * W_LAYER;
            float* sw = (float*)(F.ws + WS_SW) + (size_t)l * SWL;
            for (int r = gw; r < nrows; r += NGW) {
                const bf16* bt; float* dst; int stride;
                if (j == 0) { bt = (const bf16*)(wl + W_F1IN) + (size_t)r * D; dst = sw + SW_F1 + r; stride = 5632; }
                else if (j == 2) { bt = (const bf16*)(wl + W_F2IN) + (size_t)r * D; dst = sw + SW_F2 + r; stride = 5632; }
                else if (r < 3072) { bt = (const bf16*)(wl + W_MIXIN) + (size_t)r * D; dst = sw + SW_MIX + r; stride = 3072; }
                else { bt = (const bf16*)(F.ws + WS_WCG) + ((size_t)l * 16 + (r - 3072)) * D; dst = sw + SW_CG + (r - 3072); stride = 16; }
                const v4u w0 = *(const v4u*)(bt + 16 * F.lane), w1 = *(const v4u*)(bt + 16 * F.lane + 8);
                float wf[16];
#pragma unroll
                for (int q = 0; q < 4; ++q) { wf[2 * q] = __builtin_bit_cast(float, w0[q] << 16); wf[2 * q + 1] = __builtin_bit_cast(float, w0[q] & 0xffff0000u);
                    wf[8 + 2 * q] = __builtin_bit_cast(float, w1[q] << 16); wf[8 + 2 * q + 1] = __builtin_bit_cast(float, w1[q] & 0xffff0000u); }
#pragma unroll
                for (int b = 0; b < 4; ++b) { float s = 0.f;
#pragma unroll
                    for (int q = 0; q < 16; ++q) s += sh[b][q] * wf[q];
                    s = wave_sum(s); if (F.lane == 0) dst[(size_t)b * stride] = s; }
            }
        }
    { const float* x = (const float*)a->in[0]; const float* nw = (const float*)a->in[5]; bf16* XS = (bf16*)(F.ws + WS_XS); float* rss = (float*)(F.ws + WS_ROWSS);
        for (int row = gw; row < M; row += NGW) { const int b = row >> 12; float ss = 0.f;
#pragma unroll
            for (int j = 0; j < 4; ++j) { const int c = 4 * F.lane + 256 * j; const f32x4 v = *(const f32x4*)(x + (size_t)row * D + c);
                const f32x4 g = *(const f32x4*)(nw + c), sc = *(const f32x4*)(MOD + (size_t)b * MODW + D + c);
                ss += (v[0] * v[0] + v[1] * v[1]) + (v[2] * v[2] + v[3] * v[3]);
                const f32x4 o = v * g * (sc + 1.f);
                *(unsigned long long*)(XS + (size_t)row * D + c) = (unsigned long long)pk2(o[0], o[1]) | ((unsigned long long)pk2(o[2], o[3]) << 32); }
            ss = wave_sum(ss); if (F.lane == 0) rss[row] = ss; } }
}
}

namespace {
typedef short s16x8 __attribute__((ext_vector_type(8)));
typedef float f32x16 __attribute__((ext_vector_type(16)));
typedef unsigned u32x2v __attribute__((ext_vector_type(2)));
__device__ __forceinline__ int crow32(int r, int hi) { return (r & 3) + 8 * (r >> 2) + 4 * hi; }
__device__ __forceinline__ float logsig16(float z) { return (fminf(z, 0.f) - log1pf(expf(-fabsf(z)))) * (1.0f / 16.0f); }

__device__ __forceinline__ void conv_unit(Frame& F, ArgsP a, int l, int unit) {
    const bf16* HG = (const bf16*)(F.ws + WS_HGLU); bf16* CC = (bf16*)(F.ws + WS_CONCAT);
    const int b = unit >> 6, t0 = (unit & 63) * 64;
    LAS bf16* tile = (LAS bf16*)F.lds;
    for (int p = F.tid; p < 94 * 32; p += NTHREADS) { const int r = p >> 5, ch = (p & 31) * 8; const int t = t0 - 30 + r;
        v4u v = {0u, 0u, 0u, 0u}; if (t >= 0) v = *(const v4u*)(HG + ((size_t)b * S + t) * 256 + ch);
        *(LAS v4u*)(tile + r * 256 + ch) = v; }
    LAS float* wl = (LAS float*)(F.lds + 49152);
    { const float* cwg = (const float*)a->in[12] + (size_t)l * 31 * 256; for (int p = F.tid; p < 31 * 64; p += NTHREADS) *(LAS f32x4*)(wl + 4 * p) = *(const f32x4*)(cwg + 4 * p); }
    __syncthreads();
    const int c = F.tid & 255, half = F.tid >> 8;
    float w[31];
#pragma unroll
    for (int j = 0; j < 31; ++j) w[j] = wl[j * 256 + c];
    const float bias = ((const float*)a->in[13])[l * 256 + c], ng = ((const float*)a->in[14])[l * 256 + c], nb = ((const float*)a->in[15])[l * 256 + c];
    float acc[32];
#pragma unroll
    for (int i = 0; i < 32; ++i) acc[i] = bias;
#pragma unroll
    for (int r = 0; r < 62; ++r) { const float x = bf2f(tile[(32 * half + r) * 256 + c]);
#pragma unroll
        for (int tt = 0; tt < 32; ++tt) if (r - tt >= 0 && r - tt <= 30) acc[tt] += w[r - tt] * x; }
    bf16* dst = CC + ((size_t)b * S + t0 + 32 * half) * D + 512 + c;
#pragma unroll
    for (int tt = 0; tt < 32; ++tt) {
        const float mu = wave_sum(acc[tt]) * (1.0f / 64.0f); const float xc = acc[tt] - mu;
        const float var = wave_sum(xc * xc) * (1.0f / 64.0f);
        const float y = xc * rsqrtf(var + EPS) * ng + nb;
        dst[(size_t)tt * D] = (bf16)f2bf(y / (1.f + __expf(-y)));
    }
    __syncthreads();
}

__device__ __forceinline__ void gla_gates(Frame& F, ArgsP a, int l, const LAS float* cg, LAS float* hs, LAS float* gwl, float (&G)[32], float& Glast) {
    const int c = F.tid & 255, half = F.tid >> 8;
    { const float* gwg = (const float*)a->in[16] + (size_t)l * 16 * 256; for (int p = F.tid; p < 16 * 64; p += NTHREADS) *(LAS f32x4*)(gwl + 4 * p) = *(const f32x4*)(gwg + 4 * p); }
    __syncthreads();
    float wc[16];
#pragma unroll
    for (int r = 0; r < 16; ++r) wc[r] = gwl[r * 256 + c];
    const float gb = ((const float*)a->in[17])[l * 256 + c];
    float run = 0.f;
#pragma unroll
    for (int i = 0; i < 32; ++i) { const LAS float* cr = cg + (32 * half + i) * 16; float z = gb;
#pragma unroll
        for (int r = 0; r < 16; ++r) z += cr[r] * wc[r];
        run += logsig16(z); G[i] = run; }
    if (half == 0) hs[c] = run;
    __syncthreads();
    const float h0 = hs[c];
    __syncthreads();
    if (half == 1) {
#pragma unroll
        for (int i = 0; i < 32; ++i) G[i] += h0;
        Glast = G[31];
    } else Glast = 0.f;
}

constexpr int GP72 = 72;
__device__ __forceinline__ void gla_local_unit(Frame& F, ArgsP a, int l, int unit) {
    const int b = unit >> 6, n = unit & 63; const size_t row0 = (size_t)b * S + n * 64;
    LAS float* part = (LAS float*)F.lds;
    LAS float* cg = (LAS float*)(F.lds + 32768);
    LAS float* hs = (LAS float*)(F.lds + 36864);
    LAS bf16* keT = (LAS bf16*)(F.lds + 40960);
    LAS bf16* vT = (LAS bf16*)(F.lds + 40960 + 36864);
    const bf16* XS = (const bf16*)(F.ws + WS_XS); const bf16* wcg = (const bf16*)(F.ws + WS_WCG) + (size_t)l * 16 * D;
    {
        const int fr = F.lane & 15, fq = F.lane >> 4;
        f32x4 acc[4];
#pragma unroll
        for (int rt = 0; rt < 4; ++rt) acc[rt] = (f32x4){0.f, 0.f, 0.f, 0.f};
#pragma unroll
        for (int ks = 0; ks < 4; ++ks) { const int k0 = F.wave * 128 + ks * 32 + 8 * fq;
            const s16x8 bfr = *(const s16x8*)(wcg + (size_t)fr * D + k0);
#pragma unroll
            for (int rt = 0; rt < 4; ++rt) { const s16x8 afr = *(const s16x8*)(XS + (row0 + 16 * rt + fr) * D + k0);
                acc[rt] = __builtin_amdgcn_mfma_f32_16x16x32_bf16(afr, bfr, acc[rt], 0, 0, 0); } }
#pragma unroll
        for (int rt = 0; rt < 4; ++rt)
#pragma unroll
            for (int j = 0; j < 4; ++j) part[(F.wave * 64 + 16 * rt + 4 * fq + j) * 16 + fr] = acc[rt][j];
    }
    __syncthreads();
    {
        const float* rowss = (const float*)(F.ws + WS_ROWSS) + (size_t)(3 * l + 1) * M; const float* swcg = (const float*)(F.ws + WS_SW) + (size_t)l * SWL + SW_CG + b * 16;
        float* CG = (float*)(F.ws + WS_CG);
#pragma unroll
        for (int q = 0; q < 2; ++q) { const int o = F.tid + 512 * q, tok = o >> 4, nn = o & 15; float s = 0.f;
#pragma unroll
            for (int w8 = 0; w8 < 8; ++w8) s += part[(w8 * 64 + tok) * 16 + nn];
            const float r = rsqrtf(rowss[row0 + tok] * (1.0f / 1024.0f) + EPS);
            const float v = r * s + swcg[nn]; cg[o] = v; CG[(row0 + tok) * 16 + nn] = v; }
    }
    __syncthreads();
    float G[32], Glast;
    gla_gates(F, a, l, cg, hs, (LAS float*)(F.lds + 40960 + 2 * 36864), G, Glast);
    const int c = F.tid & 255, half = F.tid >> 8;
    if (half == 1) hs[c] = Glast;
    __syncthreads();
    Glast = hs[c];
    {
        const bf16* CK = (const bf16*)(F.ws + WS_CK) + (row0 + 32 * half) * 256 + c; const bf16* CV = (const bf16*)(F.ws + WS_CV) + (row0 + 32 * half) * 256 + c;
#pragma unroll
        for (int i = 0; i < 32; i += 2) {
            const float k0 = bf2f(CK[(size_t)i * 256]) * __expf(Glast - G[i]), k1 = bf2f(CK[(size_t)(i + 1) * 256]) * __expf(Glast - G[i + 1]);
            *(LAS unsigned*)(keT + c * GP72 + 32 * half + i) = pk2(k0, k1);
            *(LAS unsigned*)(vT + c * GP72 + 32 * half + i) = (unsigned)CV[(size_t)i * 256] | ((unsigned)CV[(size_t)(i + 1) * 256] << 16);
        }
        if (half == 1) ((float*)(F.ws + WS_DEC))[((size_t)(b * 4 + (c >> 6)) * 64 + n) * 64 + (c & 63)] = __expf(Glast);
    }
    __syncthreads();
    {
        const int h = F.wave >> 1, et = F.wave & 1, r32 = F.lane & 31, hi = F.lane >> 5;
        float* KVT = (float*)(F.ws + WS_KV) + ((size_t)(b * 4 + h) * 64 + n) * 4096;
#pragma unroll
        for (int dt = 0; dt < 2; ++dt) { f32x16 acc = {};
#pragma unroll
            for (int ks = 0; ks < 4; ++ks) { const s16x8 af = *(const LAS s16x8*)(vT + (h * 64 + 32 * et + r32) * GP72 + 16 * ks + 8 * hi);
                const s16x8 bf = *(const LAS s16x8*)(keT + (h * 64 + 32 * dt + r32) * GP72 + 16 * ks + 8 * hi);
                acc = __builtin_amdgcn_mfma_f32_32x32x16_bf16(af, bf, acc, 0, 0, 0); }
#pragma unroll
            for (int r = 0; r < 16; ++r) KVT[(size_t)(32 * et + crow32(r, hi)) * 64 + 32 * dt + r32] = acc[r]; }
    }
    __syncthreads();
}

__device__ __forceinline__ void gla_scan_unit(Frame& F, int unit) {
    const int bh = unit >> 3, idx = (unit & 7) * 512 + F.tid, d = idx & 63;
    const float* KVT = (const float*)(F.ws + WS_KV) + (size_t)bh * 64 * 4096 + idx; const float* DEC = (const float*)(F.ws + WS_DEC) + (size_t)bh * 64 * 64 + d;
    bf16* SPT = (bf16*)(F.ws + WS_SPT) + (size_t)bh * 64 * 4096 + idx;
    float s = 0.f;
    for (int n0 = 0; n0 < 64; n0 += 8) { float kv[8], dc[8];
#pragma unroll
        for (int j = 0; j < 8; ++j) { kv[j] = KVT[(size_t)(n0 + j) * 4096]; dc[j] = DEC[(n0 + j) * 64]; }
#pragma unroll
        for (int j = 0; j < 8; ++j) { SPT[(size_t)(n0 + j) * 4096] = (bf16)f2bf(s); s = dc[j] * s + kv[j]; } }
}

__device__ __forceinline__ void gla_out_unit(Frame& F, ArgsP a, int l, int unit) {
    const int b = unit >> 6, n = unit & 63; const size_t row0 = (size_t)b * S + n * 64;
    LAS float* cg = (LAS float*)F.lds;
    LAS float* hs = (LAS float*)(F.lds + 4096);
    LAS bf16* qt = (LAS bf16*)(F.lds + 8192);
    LAS bf16* kt = (LAS bf16*)(F.lds + 8192 + 36864);
    LAS bf16* vT = (LAS bf16*)(F.lds + 8192 + 2 * 36864);
    { const float* CG = (const float*)(F.ws + WS_CG) + row0 * 16;
#pragma unroll
        for (int q = 0; q < 2; ++q) cg[F.tid + 512 * q] = CG[F.tid + 512 * q]; }
    __syncthreads();
    float G[32], Glast;
    gla_gates(F, a, l, cg, hs, (LAS float*)(F.lds + 8192 + 3 * 36864), G, Glast);
    const int c = F.tid & 255, half = F.tid >> 8, hh = c >> 6, dd = c & 63;
    {
        const bf16* CQ = (const bf16*)(F.ws + WS_CQ) + (row0 + 32 * half) * 256 + c; const bf16* CK = (const bf16*)(F.ws + WS_CK) + (row0 + 32 * half) * 256 + c;
        const bf16* CV = (const bf16*)(F.ws + WS_CV) + (row0 + 32 * half) * 256 + c;
#pragma unroll
        for (int i = 0; i < 32; ++i) { const float eg = __expf(G[i]);
            qt[(hh * 64 + 32 * half + i) * GP72 + dd] = (bf16)f2bf(bf2f(CQ[(size_t)i * 256]) * 0.125f * eg);
            kt[(hh * 64 + 32 * half + i) * GP72 + dd] = (bf16)f2bf(bf2f(CK[(size_t)i * 256]) * __builtin_amdgcn_rcpf(eg)); }
#pragma unroll
        for (int i = 0; i < 32; i += 2) *(LAS unsigned*)(vT + c * GP72 + 32 * half + i) = (unsigned)CV[(size_t)i * 256] | ((unsigned)CV[(size_t)(i + 1) * 256] << 16);
    }
    __syncthreads();
    const int h = F.wave >> 1, sub = F.wave & 1, r32 = F.lane & 31, hi = F.lane >> 5;
    f32x16 am[2];
#pragma unroll
    for (int mt = 0; mt < 2; ++mt) { am[mt] = (f32x16){};
#pragma unroll
        for (int ks = 0; ks < 4; ++ks) { const s16x8 af = *(const LAS s16x8*)(kt + (h * 64 + 32 * mt + r32) * GP72 + 16 * ks + 8 * hi);
            const s16x8 bf = *(const LAS s16x8*)(qt + (h * 64 + 32 * sub + r32) * GP72 + 16 * ks + 8 * hi);
            am[mt] = __builtin_amdgcn_mfma_f32_32x32x16_bf16(af, bf, am[mt], 0, 0, 0); } }
    __syncthreads();
    { const int lq = 32 * sub + r32;
#pragma unroll
        for (int mt = 0; mt < 2; ++mt)
#pragma unroll
            for (int g4 = 0; g4 < 4; ++g4) { float v[4];
#pragma unroll
                for (int j = 0; j < 4; ++j) { const int mm = 32 * mt + 8 * g4 + 4 * hi + j; v[j] = (mm <= lq) ? am[mt][4 * g4 + j] : 0.f; }
                u32x2v w; w.x = pk2(v[0], v[1]); w.y = pk2(v[2], v[3]);
                *(LAS u32x2v*)(kt + (h * 64 + lq) * GP72 + 32 * mt + 8 * g4 + 4 * hi) = w; } }
    __syncthreads();
    const bf16* SPT = (const bf16*)(F.ws + WS_SPT) + ((size_t)(b * 4 + h) * 64 + n) * 4096;
    f32x16 o[2];
#pragma unroll
    for (int et = 0; et < 2; ++et) { o[et] = (f32x16){};
#pragma unroll
        for (int ks = 0; ks < 4; ++ks) { const s16x8 af = *(const LAS s16x8*)(vT + (h * 64 + 32 * et + r32) * GP72 + 16 * ks + 8 * hi);
            const s16x8 bf = *(const LAS s16x8*)(kt + (h * 64 + 32 * sub + r32) * GP72 + 16 * ks + 8 * hi);
            o[et] = __builtin_amdgcn_mfma_f32_32x32x16_bf16(af, bf, o[et], 0, 0, 0); }
#pragma unroll
        for (int ks = 0; ks < 4; ++ks) { const s16x8 af = *(const s16x8*)(SPT + (size_t)(32 * et + r32) * 64 + 16 * ks + 8 * hi);
            const s16x8 bf = *(const LAS s16x8*)(qt + (h * 64 + 32 * sub + r32) * GP72 + 16 * ks + 8 * hi);
            o[et] = __builtin_amdgcn_mfma_f32_32x32x16_bf16(af, bf, o[et], 0, 0, 0); } }
    float ss = 0.f;
#pragma unroll
    for (int et = 0; et < 2; ++et)
#pragma unroll
        for (int r = 0; r < 16; ++r) ss += o[et][r] * o[et][r];
    ss = add_x32(ss);
    const float rn = rsqrtf(ss * (1.0f / 64.0f) + EPS);
    const size_t row = row0 + 32 * sub + r32;
    const bf16* CR = (const bf16*)(F.ws + WS_CR) + row * 256 + h * 64; bf16* CC = (bf16*)(F.ws + WS_CONCAT) + row * D + 768 + h * 64;
    const float* gn = (const float*)a->in[18] + l * 64;
#pragma unroll
    for (int et = 0; et < 2; ++et)
#pragma unroll
        for (int g4 = 0; g4 < 4; ++g4) { const int e0 = 32 * et + 8 * g4 + 4 * hi;
            const u32x2v cr = *(const u32x2v*)(CR + e0); const f32x4 gv = *(const f32x4*)(gn + e0);
            float y[4];
#pragma unroll
            for (int j = 0; j < 4; ++j) { const float crv = __builtin_bit_cast(float, (j & 1) ? ((j < 2 ? cr.x : cr.y) & 0xffff0000u) : ((j < 2 ? cr.x : cr.y) << 16));
                y[j] = o[et][4 * g4 + j] * rn * gv[j] * (crv / (1.f + __expf(-crv))); }
            u32x2v w; w.x = pk2(y[0], y[1]); w.y = pk2(y[2], y[3]);
            *(u32x2v*)(CC + e0) = w; }
    __syncthreads();
}
}
#include <hip/hip_bf16.h>
#include <cmath>
namespace attn_body {
using bf16=__hip_bfloat16;
using bf16x8=__attribute__((ext_vector_type(8)))short;
using s16x4=__attribute__((ext_vector_type(4)))short;
using f32x16=__attribute__((ext_vector_type(16)))float;
using u32x4=__attribute__((ext_vector_type(4)))unsigned;
constexpr int BATCH=4,NHEAD=8,SEQ=4096,D=64,DM=NHEAD*D,DMO=1024;
constexpr int NW=8,QBLK=32,QB=QBLK*NW,KVBLK=64,NQB=SEQ/QB;
constexpr int ATTN_PITCH=DM, ATTN_UNIT_ROWS=QB;
__device__ __forceinline__ int crow(int r,int hi){return (r&3)+8*(r>>2)+4*hi;}
#define SBAR() __builtin_amdgcn_sched_barrier(0)
__device__ __forceinline__ void cmask(f32x16&p0,f32x16&p1,int jb,int qrel,int hi){
  const float NEG=-INFINITY; int kb=64*jb+4*hi;
  #pragma unroll
  for(int r=0;r<16;++r){int kv=kb+(r&3)+8*(r>>2); if(kv>qrel)p0[r]=NEG; if(kv+32>qrel)p1[r]=NEG;}
}

__device__ __forceinline__ void smask(f32x16&p0,f32x16&p1,unsigned keep){
  const float NEG=-INFINITY;
  #pragma unroll
  for(int r=0;r<16;++r){ if(!keep){p0[r]=NEG;p1[r]=NEG;} }
}
constexpr int NSLOT=3, SLOTB=8192;
constexpr int LDS_K=0, LDS_V=NSLOT*SLOTB, LDS_WS=2*NSLOT*SLOTB, LDS_OST=LDS_WS+NW*64*4, LDS_BYTES=LDS_OST+NW*4096;
constexpr float C2=0.125f*1.4426950408889634f;
__device__ __forceinline__ void glds16(const void*gsrc,unsigned lds_dst){unsigned keep;
  asm volatile("s_mov_b32 %0, m0\n\ts_mov_b32 m0, %2\n\ts_nop 0\n\tglobal_load_lds_dwordx4 %1, off\n\ts_mov_b32 m0, %0":"=&s"(keep):"v"(gsrc),"s"(lds_dst):"memory");}
__device__ __forceinline__ float max3f(float a,float b,float c){float r;asm("v_max3_f32 %0, %1, %2, %3":"=v"(r):"v"(a),"v"(b),"v"(c));return r;}
__device__ __forceinline__ float max2f(float a,float b){float r;asm("v_max_f32_e32 %0, %1, %2":"=v"(r):"v"(a),"v"(b));return r;}
__device__ __forceinline__ float fadd_s(float a,float b){float r;asm("v_add_f32_e32 %0, %1, %2":"=v"(r):"v"(a),"v"(b));return r;}
__device__ __forceinline__ float fsub_s(float a,float b){float r;asm("v_sub_f32_e32 %0, %1, %2":"=v"(r):"v"(a),"v"(b));return r;}
typedef float f32x2_t __attribute__((ext_vector_type(2))); typedef __bf16 bf16x2_t __attribute__((ext_vector_type(2)));
__device__ __forceinline__ unsigned cvtpk_s(float lo,float hi){f32x2_t v={lo,hi};bf16x2_t b=__builtin_convertvector(v,bf16x2_t);return __builtin_bit_cast(unsigned,b);}
#define WAIT_BAR(N) asm volatile("s_waitcnt vmcnt(" #N ") lgkmcnt(0)\n\ts_barrier":::"memory")

__device__ __forceinline__ void qkt(f32x16&p0,f32x16&p1,const char*Kslot,const bf16x8*qr,const f32x16&negm,int r32,int hi){
  const char*kb=Kslot+hi*1024+r32*16;
  #pragma unroll
  for(int d0=0;d0<4;++d0){
    const bf16x8 b0=*reinterpret_cast<const bf16x8*>(kb+d0*2048);
    const bf16x8 b1=*reinterpret_cast<const bf16x8*>(kb+d0*2048+512);
    if(d0==0){p0=__builtin_amdgcn_mfma_f32_32x32x16_bf16(b0,qr[0],negm,0,0,0);p1=__builtin_amdgcn_mfma_f32_32x32x16_bf16(b1,qr[0],negm,0,0,0);}
    else{p0=__builtin_amdgcn_mfma_f32_32x32x16_bf16(b0,qr[d0],p0,0,0,0);p1=__builtin_amdgcn_mfma_f32_32x32x16_bf16(b1,qr[d0],p1,0,0,0);}}
}
typedef __attribute__((address_space(3))) const char* lds_cptr;
typedef short v4i16_t __attribute__((ext_vector_type(4)));
__device__ __forceinline__ void kload8(bf16x8*kf,lds_cptr kp){
  kf[0]=*(const __attribute__((address_space(3))) bf16x8*)(kp);      kf[1]=*(const __attribute__((address_space(3))) bf16x8*)(kp+512);
  kf[2]=*(const __attribute__((address_space(3))) bf16x8*)(kp+2048); kf[3]=*(const __attribute__((address_space(3))) bf16x8*)(kp+2560);
  kf[4]=*(const __attribute__((address_space(3))) bf16x8*)(kp+4096); kf[5]=*(const __attribute__((address_space(3))) bf16x8*)(kp+4608);
  kf[6]=*(const __attribute__((address_space(3))) bf16x8*)(kp+6144); kf[7]=*(const __attribute__((address_space(3))) bf16x8*)(kp+6656);
}
__device__ __forceinline__ void kload2(bf16x8*kf,lds_cptr kp,int j){ kf[2*j]=*(const __attribute__((address_space(3))) bf16x8*)(kp+j*2048); kf[2*j+1]=*(const __attribute__((address_space(3))) bf16x8*)(kp+j*2048+512); }
__device__ __forceinline__ s16x4 vtr(lds_cptr p){ return __builtin_bit_cast(s16x4,__builtin_amdgcn_ds_read_tr16_b64_v4i16((__attribute__((address_space(3))) v4i16_t*)p)); }
__device__ __forceinline__ float rowmax(const f32x16&p0,const f32x16&p1){
  float a=max3f(p0[0],p0[1],p1[0]),b=max3f(p0[2],p0[3],p1[1]);a=max3f(a,p1[2],p1[3]);
  #pragma unroll
  for(int r=4;r<16;r+=4){a=max3f(a,p0[r],p0[r+1]);b=max3f(b,p0[r+2],p0[r+3]);a=max3f(a,p1[r],p1[r+1]);b=max3f(b,p1[r+2],p1[r+3]);}
  const float m=max2f(a,b);
  auto rr=__builtin_amdgcn_permlane32_swap(__float_as_uint(m),__float_as_uint(m),false,false);
  return max2f(__uint_as_float(rr[0]),__uint_as_float(rr[1]));
}
__device__ __forceinline__ void pv(f32x16*o,int vb,bf16x8 pa0,bf16x8 pa1,bf16x8 pa2,bf16x8 pa3){
  #pragma unroll
  for(int d0=0;d0<2;++d0){s16x4 lo[4],hi[4];
    #pragma unroll
    for(int ks=0;ks<4;++ks){
      asm volatile("ds_read_b64_tr_b16 %0,%1 offset:%c2":"=&v"(lo[ks]):"v"(vb),"i"(d0*4096+ks*1024):"memory");
      asm volatile("ds_read_b64_tr_b16 %0,%1 offset:%c2":"=&v"(hi[ks]):"v"(vb),"i"(d0*4096+ks*1024+512):"memory");}
    asm volatile("s_waitcnt lgkmcnt(0)":::"memory");SBAR();
    #define PK(k) (bf16x8){lo[k][0],lo[k][1],lo[k][2],lo[k][3],hi[k][0],hi[k][1],hi[k][2],hi[k][3]}
    o[d0]=__builtin_amdgcn_mfma_f32_32x32x16_bf16(pa0,PK(0),o[d0],0,0,0);
    o[d0]=__builtin_amdgcn_mfma_f32_32x32x16_bf16(pa1,PK(1),o[d0],0,0,0);
    o[d0]=__builtin_amdgcn_mfma_f32_32x32x16_bf16(pa2,PK(2),o[d0],0,0,0);
    o[d0]=__builtin_amdgcn_mfma_f32_32x32x16_bf16(pa3,PK(3),o[d0],0,0,0);
    #undef PK
  }
}

#ifndef ATTN_STORE16
#define ATTN_STORE16(p,v) (*(u32x4*)(p)=(v))
#endif
template<int THRL> __device__ __forceinline__ void attn_unit(int b,int h,int qb,const bf16*Q,const bf16*__restrict__ K,const bf16*__restrict__ V,bf16*O,const float*__restrict__ KM,char*shm,int tid){
  const int lane=tid&63,r32=lane&31,hi=lane>>5; const int wid=__builtin_amdgcn_readfirstlane(tid>>6);
  const long rowbase=(long)b*SEQ; const int q0=qb*QB;
  const bf16*Qw=Q+(rowbase+q0+wid*QBLK)*DM+h*D;
  const bf16*Kh=K+rowbase*DM+h*D,*Vh=V+rowbase*DM+h*D;
  const unsigned lds0=(unsigned)(uintptr_t)shm;
  float*wsf=(float*)(shm+LDS_WS)+wid*64;
  const bf16*ksrc=Kh+(long)lane*DM+wid*8;
  const bf16*vsrc=Vh+(long)(16*(wid&3)+(lane>>2))*DM+(wid>>2)*32+(lane&3)*8;
  const unsigned kdst=lds0+LDS_K+wid*1024, vdst=lds0+LDS_V+wid*1024;
  #define AT(t) (((t)<4)?(NT-4+(t)):((t)-4))
  #define DMA_K(t,slot) glds16(ksrc+(long)AT(t)*KVBLK*DM,(unsigned)__builtin_amdgcn_readfirstlane(kdst+(slot)))
  #define DMA_V(t,slot) glds16(vsrc+(long)AT(t)*KVBLK*DM,(unsigned)__builtin_amdgcn_readfirstlane(vdst+(slot)))
  const int vb0=(int)(lds0+LDS_V)+((lane>>4)&1)*32+(lane&3)*8+(4*hi+((lane&15)>>2))*64;
  const char*Kbase=shm+LDS_K; bf16x8 kf[8];
  const lds_cptr shm3=(lds_cptr)shm; const lds_cptr kp0=shm3+LDS_K+hi*1024+r32*16; const lds_cptr vp0=shm3+LDS_V+((lane>>4)&1)*32+(lane&3)*8+(4*hi+((lane&15)>>2))*64;
  const int NT=(q0+QB)/KVBLK;
  DMA_K(0,0);DMA_V(0,0);DMA_K(1,SLOTB);
  bf16x8 qr[4];
  #pragma unroll
  for(int d0=0;d0<4;++d0)qr[d0]=*reinterpret_cast<const bf16x8*>(&Qw[(long)r32*DM+d0*16+hi*8]);
  unsigned selmask=0u;
  { float b0=-INFINITY,b1=-INFINITY,b2=-INFINITY; int i0=-1,i1=-1,i2=-1;
    float qf[32];
    #pragma unroll
    for(int d0=0;d0<4;++d0){
      #pragma unroll
      for(int j=0;j<8;++j)qf[8*d0+j]=__builtin_bit_cast(float,((unsigned)(unsigned short)qr[d0][j])<<16);}
    for(int n=0;n<qb;++n){
      const float*km=KM+((long)(b*NHEAD+h)*16+n)*64+8*hi; float s=0.f;
      #pragma unroll
      for(int d0=0;d0<4;++d0){ const float4 ka=*reinterpret_cast<const float4*>(km+16*d0),kb=*reinterpret_cast<const float4*>(km+16*d0+4);
        s+=qf[8*d0]*ka.x+qf[8*d0+1]*ka.y+qf[8*d0+2]*ka.z+qf[8*d0+3]*ka.w+qf[8*d0+4]*kb.x+qf[8*d0+5]*kb.y+qf[8*d0+6]*kb.z+qf[8*d0+7]*kb.w; }
      s=add_x32(s);
      const bool g0=s>b0,g1=s>b1,g2=s>b2;
      b2=g1?b1:(g2?s:b2); i2=g1?i1:(g2?n:i2);
      b1=g0?b0:(g1?s:b1); i1=g0?i0:(g1?n:i1);
      b0=g0?s:b0;         i0=g0?n:i0; }
    if(i0>=0)selmask|=1u<<i0; if(i1>=0)selmask|=1u<<i1; if(i2>=0)selmask|=1u<<i2; }
  float mhat=0.f,l_reg=0.f;f32x16 o[2];o[0]=f32x16{};o[1]=f32x16{};f32x16 negm=f32x16{};asm volatile("":"+v"(negm));
  const int qrel=wid*QBLK+r32;
  #define CMASK(P0,P1,t) do{ if((t)<4)cmask(P0,P1,(t),qrel,hi); else smask(P0,P1,(selmask>>(((t)-4)>>2))&1u); }while(0)
  bool resc=false;
  #define START(P0,P1) do{ const float rm=rowmax(P0,P1); resc=false; \
    { const float dl=rm; mhat=fadd_s(mhat,dl); \
      _Pragma("unroll") for(int r=0;r<16;++r){P0[r]=fsub_s(P0[r],dl);P1[r]=fsub_s(P1[r],dl);} \
      _Pragma("unroll") for(int r=0;r<16;++r)negm[r]=-mhat; asm volatile("":"+v"(negm)); } \
    _Pragma("unroll") for(int r=0;r<16;++r)P0[r]=__builtin_amdgcn_exp2f(P0[r]); }while(0)
  #define RESC() do{ if(resc){ asm volatile("s_waitcnt lgkmcnt(0)":::"memory"); \
      _Pragma("unroll") for(int d_=0;d_<2;++d_) _Pragma("unroll") for(int r=0;r<16;++r)o[d_][r]*=wsf[crow(r,hi)]; } }while(0)
  f32x16 pA0,pA1,pB0,pB1;
  int sl_prev=0,sl_cur=0,sl_next=SLOTB;
  #define ROT() do{sl_prev=sl_cur;sl_cur=sl_next;sl_next=(sl_next==(NSLOT-1)*SLOTB)?0:sl_next+SLOTB;}while(0)
  DMA_K(2,2*SLOTB);
  WAIT_BAR(3);
  qkt(pA0,pA1,Kbase,qr,negm,r32,hi);asm volatile("s_nop 15\n\ts_nop 7":"+v"(pA0),"+v"(pA1));CMASK(pA0,pA1,0);
  START(pA0,pA1);
  _Pragma("unroll") for(int r=0;r<16;++r)pA1[r]=__builtin_amdgcn_exp2f(pA1[r]);
  WAIT_BAR(0);
  DMA_K(3,0);DMA_V(1,SLOTB);
  ROT();
  kload8(kf,kp0+sl_cur);
  WAIT_BAR(2);
  s16x4 vlo[8],vhi[8]; u32x4 pw0,pw1,pw2,pw3;
  #define PKW(P,B) cvtpk_s(P[B],P[B+1])
  #define PAF(k) __builtin_bit_cast(bf16x8,pw##k)
  #define VFR(i) (bf16x8){vlo[i][0],vlo[i][1],vlo[i][2],vlo[i][3],vhi[i][0],vhi[i][1],vhi[i][2],vhi[i][3]}
  #define PIN(x) asm volatile("":"+v"(x))
  #define MX3(a,b,c) __builtin_fmaxf(__builtin_fmaxf((a),(b)),(c))
  #define GAPA(MF,A0,A1,A2,A3,W0,W1,PW) do{ MF; sacc+=A0; sacc+=A1; sacc+=A2; sacc+=A3; PIN(sacc); W0; W1; PIN(PW); SBAR(); }while(0)
  #define EX(v) __builtin_amdgcn_exp2f(v)
  #define GAPB(MF,X,B) do{ MF; X[B]=EX(X[B]); X[B+1]=EX(X[B+1]); X[B+2]=EX(X[B+2]); X[B+3]=EX(X[B+3]); PIN(X); SBAR(); }while(0)
  #define VRD(i) do{ vlo[i]=vtr(vp_+(((i)>>2)*4096+((i)&3)*1024)); vhi[i]=vtr(vp_+(((i)>>2)*4096+((i)&3)*1024+512)); }while(0)
  #define KRD(G,j) do{ if(G){ kload2(kf,kp0+sl_next,j); SBAR(); } }while(0)
  #define STEP(C0,C1,P0,P1,t,GK,GV,GL) do{ SBAR(); \
    const lds_cptr vp_=vp0+sl_prev; \
    VRD(0); SBAR(); float sacc=(P0[0]+P0[1]); \
    GAPA(C0=__builtin_amdgcn_mfma_f32_32x32x16_bf16(kf[0],qr[0],negm,0,0,0), P0[2],P0[3],P0[4],P0[5],     pw0[0]=PKW(P0,0), pw0[1]=PKW(P0,2), pw0); \
    VRD(4); SBAR(); GAPA(C1=__builtin_amdgcn_mfma_f32_32x32x16_bf16(kf[1],qr[0],negm,0,0,0), P0[6],P0[7],P0[8],P0[9],     pw0[2]=PKW(P0,4), pw0[3]=PKW(P0,6), pw0); \
    VRD(1); SBAR(); GAPA(C0=__builtin_amdgcn_mfma_f32_32x32x16_bf16(kf[2],qr[1],C0,0,0,0),   P0[10],P0[11],P0[12],P0[13], pw1[0]=PKW(P0,8), pw1[1]=PKW(P0,10), pw1); \
    VRD(5); SBAR(); GAPA(C1=__builtin_amdgcn_mfma_f32_32x32x16_bf16(kf[3],qr[1],C1,0,0,0),   P0[14],P0[15],P1[0],P1[1],   pw1[2]=PKW(P0,12),pw1[3]=PKW(P0,14), pw1); \
    VRD(2); SBAR(); GAPA(C0=__builtin_amdgcn_mfma_f32_32x32x16_bf16(kf[4],qr[2],C0,0,0,0),   P1[2],P1[3],P1[4],P1[5],     pw2[0]=PKW(P1,0), pw2[1]=PKW(P1,2), pw2); \
    VRD(6); SBAR(); GAPA(C1=__builtin_amdgcn_mfma_f32_32x32x16_bf16(kf[5],qr[2],C1,0,0,0),   P1[6],P1[7],P1[8],P1[9],     pw2[2]=PKW(P1,4), pw2[3]=PKW(P1,6), pw2); \
    VRD(3); SBAR(); GAPA(C0=__builtin_amdgcn_mfma_f32_32x32x16_bf16(kf[6],qr[3],C0,0,0,0),   P1[10],P1[11],P1[12],P1[13], pw3[0]=PKW(P1,8), pw3[1]=PKW(P1,10), pw3); \
    VRD(7); SBAR(); GAPA(C1=__builtin_amdgcn_mfma_f32_32x32x16_bf16(kf[7],qr[3],C1,0,0,0),   P1[14],P1[15],0.f,0.f,       pw3[2]=PKW(P1,12),pw3[3]=PKW(P1,14), pw3); \
    l_reg+=sacc; \
    if(GK){DMA_K((t)+3,sl_cur);} if(GV){DMA_V((t)+1,sl_next);} \
    CMASK(C0,C1,t); \
    { float a=MX3(C0[0],C0[1],C1[0]),b=MX3(C0[2],C0[3],C1[1]); a=MX3(a,C1[2],C1[3]); \
      _Pragma("unroll") for(int r=4;r<16;r+=4){a=MX3(a,C0[r],C0[r+1]);b=MX3(b,C0[r+2],C0[r+3]);a=MX3(a,C1[r],C1[r+1]);b=MX3(b,C1[r+2],C1[r+3]);} \
      float rm=__builtin_fmaxf(a,b); { auto rr=__builtin_amdgcn_permlane32_swap(__float_as_uint(rm),__float_as_uint(rm),false,false); rm=__builtin_fmaxf(__uint_as_float(rr[0]),__uint_as_float(rr[1])); } \
      resc=false; \
      if(__builtin_expect(__any(rm>(float)THRL),0)){ const float dl=__builtin_fmaxf(rm,0.f); mhat+=dl; \
        _Pragma("unroll") for(int r=0;r<16;++r){C0[r]-=dl;C1[r]-=dl;} \
        _Pragma("unroll") for(int r=0;r<16;++r)negm[r]=-mhat; asm volatile("":"+v"(negm)); \
        const float f=__builtin_amdgcn_exp2f(-dl); l_reg*=f; if(hi==0)wsf[r32]=f; resc=true; } } \
    SBAR(); \
    GAPB(o[0]=__builtin_amdgcn_mfma_f32_32x32x16_bf16(PAF(0),VFR(0),o[0],0,0,0), C0,0); \
    GAPB(o[1]=__builtin_amdgcn_mfma_f32_32x32x16_bf16(PAF(0),VFR(4),o[1],0,0,0), C0,4); \
    KRD(GL,0); GAPB(o[0]=__builtin_amdgcn_mfma_f32_32x32x16_bf16(PAF(1),VFR(1),o[0],0,0,0), C0,8); \
    KRD(GL,1); GAPB(o[1]=__builtin_amdgcn_mfma_f32_32x32x16_bf16(PAF(1),VFR(5),o[1],0,0,0), C0,12); \
    KRD(GL,2); GAPB(o[0]=__builtin_amdgcn_mfma_f32_32x32x16_bf16(PAF(2),VFR(2),o[0],0,0,0), C1,0); \
    KRD(GL,3); GAPB(o[1]=__builtin_amdgcn_mfma_f32_32x32x16_bf16(PAF(2),VFR(6),o[1],0,0,0), C1,4); \
    GAPB(o[0]=__builtin_amdgcn_mfma_f32_32x32x16_bf16(PAF(3),VFR(3),o[0],0,0,0), C1,8); \
    GAPB(o[1]=__builtin_amdgcn_mfma_f32_32x32x16_bf16(PAF(3),VFR(7),o[1],0,0,0), C1,12); \
    }while(0)
  int t=1;
  for(;t+5<NT;t+=2){
    STEP(pB0,pB1,pA0,pA1,t,true,true,true);     WAIT_BAR(2); RESC(); ROT();
    STEP(pA0,pA1,pB0,pB1,t+1,true,true,true);   WAIT_BAR(2); RESC(); ROT();
  }
  #define ENDW(tt) do{ if((tt)+3<NT){WAIT_BAR(2);} else if((tt)+2<NT){WAIT_BAR(1);} else {WAIT_BAR(0);} }while(0)
  for(;t+1<NT;t+=2){
    STEP(pB0,pB1,pA0,pA1,t,(t+3<NT),(t+1<NT),(t+1<NT));       ENDW(t);   RESC(); ROT();
    STEP(pA0,pA1,pB0,pB1,t+1,(t+4<NT),(t+2<NT),(t+2<NT));     ENDW(t+1); RESC(); ROT();
  }
  STEP(pB0,pB1,pA0,pA1,NT-1,false,false,false); RESC();
  { float sacc=pB0[0]+pB0[1]; _Pragma("unroll") for(int r=2;r<16;++r)sacc+=pB0[r]; _Pragma("unroll") for(int r=0;r<16;++r)sacc+=pB1[r]; l_reg+=sacc;
    pw0=(u32x4){PKW(pB0,0),PKW(pB0,2),PKW(pB0,4),PKW(pB0,6)};pw1=(u32x4){PKW(pB0,8),PKW(pB0,10),PKW(pB0,12),PKW(pB0,14)};pw2=(u32x4){PKW(pB1,0),PKW(pB1,2),PKW(pB1,4),PKW(pB1,6)};pw3=(u32x4){PKW(pB1,8),PKW(pB1,10),PKW(pB1,12),PKW(pB1,14)};
    SBAR(); pv(o,vb0+sl_cur,PAF(0),PAF(1),PAF(2),PAF(3)); }
  #undef PKW
  #undef PAF
  #undef VFR
  #undef PIN
  #undef MX3
  #undef GAPA
  #undef GAPB
  #undef EX
  #undef VRD
  #undef KRD
  #undef STEP
  #undef ENDW
  {auto rr=__builtin_amdgcn_permlane32_swap(__float_as_uint(l_reg),__float_as_uint(l_reg),false,false);l_reg=__uint_as_float(rr[0])+__uint_as_float(rr[1]);}
  if(hi==0)wsf[32+r32]=l_reg;asm volatile("s_waitcnt lgkmcnt(0)":::"memory");
  float rli[16];
  #pragma unroll
  for(int r=0;r<16;++r)rli[r]=__builtin_amdgcn_rcpf(wsf[32+crow(r,hi)]);
  bf16*Ow=O+(rowbase+q0+wid*QBLK)*DMO+h*D;
  { bf16*stg=(bf16*)(shm+LDS_OST)+wid*2048;
    #pragma unroll
    for(int r=0;r<16;++r){const int orow=crow(r,hi);
      #pragma unroll
      for(int d0=0;d0<2;++d0)stg[orow*64+d0*32+r32]=__float2bfloat16(o[d0][r]*rli[r]);}
    asm volatile("s_waitcnt lgkmcnt(0)":::"memory");
    #pragma unroll
    for(int i=0;i<4;++i){const int row=i*8+(lane>>3),ch=lane&7; const u32x4 v=*(const u32x4*)(stg+row*64+ch*8); ATTN_STORE16(Ow+(long)row*DMO+ch*8,v);} }
  asm volatile("s_waitcnt lgkmcnt(0)\n\ts_barrier":::"memory");
  #undef DMA_K
  #undef AT
  #undef DMA_V
  #undef CMASK
  #undef START
  #undef RESC
  #undef ROT
}
constexpr int ATTN_LDS_BYTES=LDS_BYTES;
struct AttnTensors { const bf16* Q; const bf16* K; const bf16* V; bf16* O; const float* KM; };
struct AttnUnit { int bh; int qb; };
struct StaticOrder {
  int vcu;
  __device__ __forceinline__ explicit StaticOrder(int grid,int block):vcu((block%8)*(grid/8)+block/8){}
  __device__ __forceinline__ bool next(int i,AttnUnit&u)const{ if(i>=2)return false; const int s=vcu&7; u.bh=vcu>>3; u.qb=(i==0)?15-s:s; return true; }
  __device__ __forceinline__ void a_ready(const AttnUnit&)const{}
  __device__ __forceinline__ void done(const AttnUnit&)const{}
};
template<class Sched,int THRL=8> __device__ __forceinline__ void attn_phase(char*lds,const AttnTensors&T,const Sched&S,int tid_wave){
  AttnUnit u;
  for(int i=0;S.next(i,u);++i){ int l_; asm volatile("v_mbcnt_lo_u32_b32 %0, -1, 0\n\tv_mbcnt_hi_u32_b32 %0, -1, %0":"=v"(l_)); const int t_=tid_wave*64+l_;
    S.a_ready(u); attn_unit<THRL>(u.bh/NHEAD,u.bh%NHEAD,u.qb,T.Q,T.K,T.V,T.O,T.KM,lds,t_); S.done(u); }
}
#undef SBAR
#undef WAIT_BAR
}
namespace {
#define XB_TMO      128
#define XB_XCNT(j)  (256  + 64 * (j))
#define XB_XSUB(j)  (1280 + 64 * (j))
#define XB_XGEN(j)  (2304 + 64 * (j))
#define XB_TOP      3328
#define XB_TOPGEN   3392
#define XCD_BAR_WORDS 3456
#define XB_SPIN_CAP (1u << 18)

__device__ __forceinline__ unsigned xb_ld(unsigned* p)              { return __hip_atomic_load(p, __ATOMIC_RELAXED, __HIP_MEMORY_SCOPE_AGENT); }
__device__ __forceinline__ unsigned xb_add(unsigned* p, unsigned v) { return __hip_atomic_fetch_add(p, v, __ATOMIC_RELAXED, __HIP_MEMORY_SCOPE_AGENT); }
__device__ __forceinline__ unsigned xb_xcc_id() { return (unsigned)__builtin_amdgcn_s_getreg((3 << 11) | 20) & 0xFu; }
#define XB_SPIN(cond, bar) do { unsigned _sp = 0; while (cond) { __builtin_amdgcn_s_sleep(1); \
    if ((++_sp & 255u) == 0u) { if (xb_ld(&(bar)[XB_TMO])) break; if (_sp > XB_SPIN_CAP) { atomicAdd(&(bar)[XB_TMO], 1u); break; } } } } while (0)

struct XcdBarrier {
    unsigned* bar; unsigned x;
    volatile LAS unsigned* st;
};

__device__ __forceinline__ XcdBarrier xcd_barrier_post(unsigned* bar, volatile LAS unsigned* st, int tid) {
    XcdBarrier b; b.bar = bar; b.x = xb_xcc_id(); b.st = st;
    if (tid == 0) (void)xb_add(&bar[XB_XCNT(b.x)], 1u);
    return b;
}
__device__ __forceinline__ void xcd_barrier_complete(unsigned* bar, unsigned x, unsigned& nloc, unsigned& nx) {
    const unsigned G = GRID;
    unsigned sum, cnt, mine, sp = 0u;
    for (;;) {
        sum = 0u; cnt = 0u; mine = 0u;
#pragma unroll
        for (unsigned j = 0; j < 16; ++j) { const unsigned c = xb_ld(&bar[XB_XCNT(j)]); sum += c; cnt += (c > 0u) ? 1u : 0u; mine = (j == x) ? c : mine; }
        if (sum == G) break;
        __builtin_amdgcn_s_sleep(1);
        if ((++sp & 255u) == 0u) { if (xb_ld(&bar[XB_TMO])) break; if (sp > XB_SPIN_CAP) { atomicAdd(&bar[XB_TMO], 1u); break; } }
    }
    nloc = mine > 0u ? mine : 1u; nx = cnt > 0u ? cnt : 1u;
}

__device__ __forceinline__ void xcd_barrier(const XcdBarrier& b, int tid) {
    asm volatile("s_waitcnt vmcnt(0)" ::: "memory");
    __syncthreads();
    if (tid == 0) {
        unsigned* bar = b.bar;
        __builtin_amdgcn_s_waitcnt(0);
        unsigned nloc = b.st[0], nx = b.st[1];
        if (nloc == 0u) { xcd_barrier_complete(bar, b.x, nloc, nx); b.st[0] = nloc; b.st[1] = nx; }
        const unsigned old = xb_add(&bar[XB_XSUB(b.x)], 1u);
        const unsigned gen = old / nloc;
        if (old + 1u == (gen + 1u) * nloc) {
            __builtin_amdgcn_fence(__ATOMIC_RELEASE, "agent");
            asm volatile("s_waitcnt vmcnt(0)" ::: "memory");
            const unsigned og = xb_add(&bar[XB_TOP], 1u);
            const unsigned tg = og / nx;
            if (og + 1u == (tg + 1u) * nx) xb_add(&bar[XB_TOPGEN], 1u);
            else XB_SPIN(xb_ld(&bar[XB_TOPGEN]) == tg, bar);
            __builtin_amdgcn_fence(__ATOMIC_ACQUIRE, "agent");
            xb_add(&bar[XB_XGEN(b.x)], 1u);
            asm volatile("s_waitcnt vmcnt(0)" ::: "memory");
        } else {
            XB_SPIN(xb_ld(&bar[XB_XGEN(b.x)]) == gen, bar);
            __builtin_amdgcn_fence(__ATOMIC_ACQUIRE, "agent");
            asm volatile("s_waitcnt vmcnt(0)" ::: "memory");
        }
    }
    __syncthreads();
}
}
#ifndef FAST_ATTN
#define FAST_ATTN 1
#endif

namespace {
constexpr int NPHASES = 2 + 9 * DEPTH;
__global__ void __launch_bounds__(NTHREADS, 2) fwd(Args args) {
    extern __shared__ __attribute__((aligned(16))) unsigned char lds_raw[];
    Frame F;
    F.lds = (LAS unsigned char*)lds_raw;
    F.wave = __builtin_amdgcn_readfirstlane(threadIdx.x >> 6);
    F.G = GRID; { const int bx = blockIdx.x; F.vcu = (bx % 8) * (GRID / 8) + bx / 8; }
    volatile LAS unsigned* MISC = (volatile LAS unsigned*)(F.lds + LDS_BYTES - 128);
    { int l0_; asm volatile("v_mbcnt_lo_u32_b32 %0, -1, 0\n\tv_mbcnt_hi_u32_b32 %0, -1, %0" : "=v"(l0_)); if (F.wave == 0 && l0_ < 32) MISC[l0_] = 0u; }
    __syncthreads();
    XcdBarrier bar;
    { int l0_; asm volatile("v_mbcnt_lo_u32_b32 %0, -1, 0\n\tv_mbcnt_hi_u32_b32 %0, -1, %0" : "=v"(l0_));
      bar = xcd_barrier_post((unsigned*)(args.ws + WS_CTL) + 4096, MISC + 8, F.wave * 64 + l0_); }
    if (args.ph_lo < 0) cooperative_groups::this_grid().sync();
    for (int ph = args.ph_lo; ph < args.ph_hi; ++ph) {
        if (ph > args.ph_lo) { int l0_; asm volatile("v_mbcnt_lo_u32_b32 %0, -1, 0\n\tv_mbcnt_hi_u32_b32 %0, -1, %0" : "=v"(l0_)); xcd_barrier(bar, F.wave * 64 + l0_); }
        ArgsP ap = (ArgsP)__builtin_amdgcn_kernarg_segment_ptr(); asm volatile("" : "+s"(ap));
        unsigned char* ws = ap->ws; F.ws = ws;
#define FRESH_TID() do { int l_; asm volatile("v_mbcnt_lo_u32_b32 %0, -1, 0\n\tv_mbcnt_hi_u32_b32 %0, -1, %0" : "=v"(l_)); const int t_ = F.wave * 64 + l_; F.tid = t_; F.lane = l_; } while (0)
#ifndef EN_MASK
#define EN_MASK 63
#endif
        if (ph == 0) { FRESH_TID(); if (EN_MASK & 1) p0a(F, ap); continue; }
        if (ph == 1) { FRESH_TID(); if (EN_MASK & 2) p0b(F, ap); continue; }
        const int l = (ph - 2) / 9, sub = (ph - 2) % 9;
        const unsigned char* wl = ws + WS_W + (size_t)l * W_LAYER;
        const float* xin0 = (l == 0) ? (const float*)ap->in[0] : (const float*)ap->out;
        if ((EN_MASK & 4) && (sub == 0 || sub == 7)) {
            FRESH_TID();
            const int st = 3 * l + (sub == 0 ? 0 : 2);
            pg8::Gemm g{(const pg8::bf16_t*)(ws + WS_XS), (const pg8::bf16_t*)(wl + (sub == 0 ? W_F1IN : W_F2IN)), M, 2 * DFF, D};
            pg8::StaticOrder So; So.init(M, 2 * DFF, GRID, (int)blockIdx.x);
            pg8::EpiSwiGLU E{ws, st, l * SWL + (sub == 0 ? SW_F1 : SW_F2)};
            pg8::gemm_phase<pg8::EpiSwiGLU, pg8::StaticOrder, true, true>(F.lds, g, So, E, F.tid);
        } else if ((EN_MASK & 8) && (sub == 1 || sub == 8)) {
            FRESH_TID();
            const int nst = 3 * l + (sub == 1 ? 1 : 3);
            pg8::Gemm g{(const pg8::bf16_t*)(ws + WS_HMID), (const pg8::bf16_t*)(wl + (sub == 1 ? W_F1OUT : W_F2OUT)), M, D, DFF};
            pg8::StaticOrder So; So.init(M, D, GRID, (int)blockIdx.x);
            pg8::EpiResid E{(sub == 1) ? xin0 : (const float*)ap->out, ap->out, ws, l * NB * MODW + (sub == 1 ? 2 : 8) * D, 0.5f, (nst < 6) ? nst : -1};
            pg8::gemm_phase<pg8::EpiResid, pg8::StaticOrder, true, true>(F.lds, g, So, E, F.tid);
        } else if ((EN_MASK & 16) && sub == 2) {
            FRESH_TID();
            pg8::Gemm g{(const pg8::bf16_t*)(ws + WS_XS), (const pg8::bf16_t*)(wl + W_MIXIN), M, 3072, D};
            pg8::StaticOrder So; So.init(M, 3072, GRID, (int)blockIdx.x);
            pg8::EpiMixIn E{ws, (const float*)ap->in[10] + l * 64, (const float*)ap->in[11] + l * 64, l, QSCALE};
            pg8::gemm_phase<pg8::EpiMixIn, pg8::StaticOrder, true, true>(F.lds, g, So, E, F.tid);
        } else if (sub == 3) {
            FRESH_TID();
            for (int u = F.vcu; u < 512; u += GRID) { if (u < 256) gla_local_unit(F, ap, l, u); else conv_unit(F, ap, l, u - 256); }
        } else if (sub == 4) {
            FRESH_TID();
            for (int u = F.vcu; u < 128; u += GRID) gla_scan_unit(F, u);
#ifndef FAST_ATTN
#define FAST_ATTN 1
#endif
#if FAST_ATTN
            { const attn_body::AttnTensors AT{(const attn_body::bf16*)(ws + WS_QB), (const attn_body::bf16*)(ws + WS_KB), (const attn_body::bf16*)(ws + WS_VB), (attn_body::bf16*)(ws + WS_CONCAT), (const float*)(ws + WS_KMEAN) + (size_t)l * 32768};
              const attn_body::StaticOrder So(GRID, (int)blockIdx.x);
              __syncthreads();
              attn_body::attn_phase<attn_body::StaticOrder>((char*)lds_raw, AT, So, F.wave); }
#endif
        } else if (sub == 5) {
            FRESH_TID();
            for (int u = F.vcu; u < 256; u += GRID) gla_out_unit(F, ap, l, u);
        } else if ((EN_MASK & 32) && sub == 6) {
            FRESH_TID();
            const int nst = 3 * l + 2;
            pg8::Gemm g{(const pg8::bf16_t*)(ws + WS_CONCAT), (const pg8::bf16_t*)(wl + W_MIXOUT), M, D, D};
            pg8::StaticOrder So; So.init(M, D, GRID, (int)blockIdx.x);
            pg8::EpiResid E{(const float*)ap->out, ap->out, ws, l * NB * MODW + 5 * D, 1.0f, nst};
            pg8::gemm_phase<pg8::EpiResid, pg8::StaticOrder, true, true>(F.lds, g, So, E, F.tid);
        }
    }
}

__global__ void norm_xs_kernel(const float* x, const float* gp, bf16* XS, float* rowss) {
    const int row = blockIdx.x * 4 + (threadIdx.x >> 6), lane = threadIdx.x & 63, b = row / S;
    float ss = 0.f;
    for (int j = 0; j < 16; ++j) { const int c = lane + 64 * j; const float v = x[(size_t)row * D + c]; ss += v * v; XS[(size_t)row * D + c] = (bf16)f2bf(v * gp[b * D + c]); }
    ss = wave_sum(ss); if (lane == 0) rowss[row] = ss;
}
__global__ void norm_mod_kernel(const float* x, const float* gain, const float* shift, const float* scale, bf16* h) {
    const int row = blockIdx.x * 4 + (threadIdx.x >> 6), lane = threadIdx.x & 63, b = row / S;
    const float* xr = x + (size_t)row * D;
    float v[16], ss = 0.f;
#pragma unroll
    for (int j = 0; j < 16; ++j) { v[j] = xr[lane + 64 * j]; ss += v[j] * v[j]; }
    ss = wave_sum(ss);
    const float r = rsqrtf(ss / D + EPS);
#pragma unroll
    for (int j = 0; j < 16; ++j) { const int c = lane + 64 * j; h[(size_t)row * D + c] = (bf16)f2bf(v[j] * r * gain[c] * (1.f + scale[b * MODW + c]) + shift[b * MODW + c]); }
}
struct ProjDst { bf16 *QB, *KB, *VB, *BU, *CQ, *CK, *CV, *CR; float* CG; };
template <int EPI>
__global__ void gemm_kernel(const bf16* A, const float* B, float* C, int N, int K, int ldb, const float* gate, float coef, ProjDst pd) {
    __shared__ float As[16][65];
    __shared__ float Bs[16][64];
    const int tid = threadIdx.x, tx = tid & 15, ty = tid >> 4;
    const int m0 = blockIdx.y * 64, n0 = blockIdx.x * 64;
    float acc[4][4] = {};
    for (int k0 = 0; k0 < K; k0 += 16) {
#pragma unroll
        for (int i = 0; i < 4; ++i) { const int e = tid + 256 * i, r = e >> 4, kk = e & 15; As[kk][r] = bf2f(A[(size_t)(m0 + r) * K + k0 + kk]); }
#pragma unroll
        for (int i = 0; i < 4; ++i) { const int e = tid + 256 * i, kk = e >> 6, cc = e & 63; const int n = n0 + cc; Bs[kk][cc] = (n < N) ? B[(size_t)(k0 + kk) * ldb + n] : 0.f; }
        __syncthreads();
#pragma unroll
        for (int kk = 0; kk < 16; ++kk) {
            float a[4], bb[4];
#pragma unroll
            for (int i = 0; i < 4; ++i) { a[i] = As[kk][ty * 4 + i]; bb[i] = Bs[kk][tx * 4 + i]; }
#pragma unroll
            for (int i = 0; i < 4; ++i)
#pragma unroll
                for (int j = 0; j < 4; ++j) acc[i][j] += a[i] * bb[j];
        }
        __syncthreads();
    }
#pragma unroll
    for (int i = 0; i < 4; ++i)
#pragma unroll
        for (int j = 0; j < 4; ++j) { const int m = m0 + ty * 4 + i, n = n0 + tx * 4 + j; if (n >= N) continue; const float v = acc[i][j];
            if (EPI == 2) { const int b = m / S; C[(size_t)m * D + n] += coef * gate[b * MODW + n] * v; }
            else {
                if (n < 512) pd.QB[(size_t)m * 512 + n] = (bf16)f2bf(v);
                else if (n < 1024) pd.KB[(size_t)m * 512 + n - 512] = (bf16)f2bf(v);
                else if (n < 1536) pd.VB[(size_t)m * 512 + n - 1024] = (bf16)f2bf(v);
                else if (n < 2048) pd.BU[(size_t)m * 512 + n - 1536] = (bf16)f2bf(v);
                else if (n < 2304) pd.CQ[(size_t)m * 256 + n - 2048] = (bf16)f2bf(v);
                else if (n < 2560) pd.CK[(size_t)m * 256 + n - 2304] = (bf16)f2bf(v);
                else if (n < 2816) pd.CV[(size_t)m * 256 + n - 2560] = (bf16)f2bf(v);
                else if (n < 3072) pd.CR[(size_t)m * 256 + n - 2816] = (bf16)f2bf(v);
                else pd.CG[(size_t)m * 16 + n - 3072] = v;
            } }
}
__global__ void cg_kernel(const bf16* XS, const float* rowss, const bf16* wcg, const float* swcg, float* CG) {
    const int row = blockIdx.x * 4 + (threadIdx.x >> 6), lane = threadIdx.x & 63, b = row / S;
    float xv[16];
#pragma unroll
    for (int q = 0; q < 16; ++q) xv[q] = bf2f(XS[(size_t)row * D + 16 * lane + q]);
    const float r = rsqrtf(rowss[row] / D + EPS);
    for (int n = 0; n < 16; ++n) { float s = 0.f;
#pragma unroll
        for (int q = 0; q < 16; ++q) s += xv[q] * bf2f(wcg[(size_t)n * D + 16 * lane + q]);
        s = wave_sum(s); if (lane == 0) CG[(size_t)row * 16 + n] = r * s + swcg[b * 16 + n]; }
}
__global__ void glu_kernel(const bf16* BU, bf16* HGLU) {
    const int i = blockIdx.x * 256 + threadIdx.x; const int row = i >> 8, c = i & 255;
    HGLU[i] = (bf16)f2bf(bf2f(BU[(size_t)row * 512 + c]) * sigmoid_f(bf2f(BU[(size_t)row * 512 + 256 + c])));
}
__global__ void qk_prep_kernel(bf16* QB, bf16* KB, const int* positions, const float* qn, const float* kn) {
    const int gw = blockIdx.x * 4 + (threadIdx.x >> 6), lane = threadIdx.x & 63;
    const int row = gw >> 4, which = (gw >> 3) & 1, h = gw & 7;
    bf16* p = (which ? KB : QB) + (size_t)row * 512 + h * 64;
    const float v = bf2f(p[lane]);
    const float ss = wave_sum(v * v);
    const float y = v * rsqrtf(ss / 64.f + EPS) * (which ? kn[lane] : qn[lane]);
    const float yp = __shfl_xor(y, 32);
    const float ang = (float)positions[row] * INV_FREQ[lane & 31];
    const float cs = cosf(ang), sn = sinf(ang);
    const float o = (lane < 32) ? (y * cs - yp * sn) : (y * cs + yp * sn);
    p[lane] = (bf16)f2bf(which ? o : o * QSCALE);
}
__global__ void kmean_kernel(const bf16* KB, float* kmean) {
    const int idx = blockIdx.x * 256 + threadIdx.x;
    const int d = idx & 63, blk = (idx >> 6) & 15, h = (idx >> 10) & 7, b = idx >> 13;
    float s = 0.f;
    for (int r = 0; r < 256; ++r) s += bf2f(KB[(size_t)(b * S + blk * 256 + r) * 512 + h * 64 + d]);
    kmean[idx] = s / 256.f;
}
__global__ void attn_kernel(const bf16* QB, const bf16* KB, const bf16* VB, const float* kmean, bf16* concat) {
    const int gw = blockIdx.x * 4 + (threadIdx.x >> 6), lane = threadIdx.x & 63;
    const int h = gw & 7, row = gw >> 3, b = row / S, t = row % S, qb = t >> 8;
    const float qd = bf2f(QB[(size_t)row * 512 + h * 64 + lane]);
    int sel[3] = {-1, -1, -1};
    {
        float g[16];
#pragma unroll
        for (int n = 0; n < 16; ++n) { const float pr = qd * kmean[((b * 8 + h) * 16 + n) * 64 + lane]; g[n] = (n < qb) ? wave_sum(pr) : -1e30f; }
#pragma unroll
        for (int s3 = 0; s3 < 3; ++s3) { float best = -3e38f; int bi = -1;
#pragma unroll
            for (int n = 0; n < 16; ++n) { const bool taken = (n == sel[0]) || (n == sel[1]) || (n == sel[2]); if (!taken && g[n] > best) { best = g[n]; bi = n; } }
            sel[s3] = bi; }
    }
    int blks[4]; bool ok[4];
    blks[0] = qb; ok[0] = true;
#pragma unroll
    for (int s3 = 0; s3 < 3; ++s3) { ok[s3 + 1] = (sel[s3] >= 0) && (sel[s3] < qb); blks[s3 + 1] = ok[s3 + 1] ? sel[s3] : 0; }
    float sc[16];
    float mx = -3e38f;
#pragma unroll
    for (int s4 = 0; s4 < 4; ++s4)
#pragma unroll
        for (int r = 0; r < 4; ++r) {
            const int key = blks[s4] * 256 + r * 64 + lane;
            const bf16* kp = KB + (size_t)(b * S + key) * 512 + h * 64;
            float dot = 0.f;
            for (int d = 0; d < 64; ++d) dot += __shfl(qd, d) * bf2f(kp[d]);
            const bool valid = ok[s4] && (s4 > 0 || key <= t);
            sc[s4 * 4 + r] = valid ? dot : -3e38f;
            mx = fmaxf(mx, sc[s4 * 4 + r]);
        }
    mx = wave_max(mx);
    float sum = 0.f;
#pragma unroll
    for (int i = 0; i < 16; ++i) { sc[i] = (sc[i] > -1e38f) ? exp2f(sc[i] - mx) : 0.f; sum += sc[i]; }
    sum = wave_sum(sum);
    float o = 0.f;
#pragma unroll
    for (int s4 = 0; s4 < 4; ++s4)
#pragma unroll
        for (int r = 0; r < 4; ++r) {
            const bf16* vp = VB + (size_t)(b * S + blks[s4] * 256 + r * 64) * 512 + h * 64 + lane;
            for (int j = 0; j < 64; ++j) o += __shfl(sc[s4 * 4 + r], j) * bf2f(vp[(size_t)j * 512]);
        }
    concat[(size_t)row * D + h * 64 + lane] = (bf16)f2bf(o / sum);
}
__global__ void conv_kernel(const bf16* HGLU, const float* cw, const float* cb, const float* ng, const float* nb, bf16* concat) {
    const int gw = blockIdx.x * 4 + (threadIdx.x >> 6), lane = threadIdx.x & 63;
    const int g = gw & 3, row = gw >> 2, t = row % S, ch = g * 64 + lane;
    float acc = cb[ch];
    for (int j = 0; j < 31; ++j) { const int tt = t - 30 + j; if (tt < 0) continue; acc += cw[j * 256 + ch] * bf2f(HGLU[(size_t)(row - 30 + j) * 256 + ch]); }
    const float mu = wave_sum(acc) / 64.f;
    const float xc = acc - mu;
    const float var = wave_sum(xc * xc) / 64.f;
    const float y = xc * rsqrtf(var + EPS) * ng[ch] + nb[ch];
    concat[(size_t)row * D + 512 + ch] = (bf16)f2bf(silu_f(y));
}
__global__ void gla_kernel(const float* CG, const bf16* CQ, const bf16* CK, const bf16* CV, const float* gw_, const float* gb, float* graw) {
    const int gwv = blockIdx.x * 4 + (threadIdx.x >> 6), lane = threadIdx.x & 63;
    const int e = gwv & 63, h = (gwv >> 6) & 3, b = gwv >> 8;
    float wcol[16];
#pragma unroll
    for (int r = 0; r < 16; ++r) wcol[r] = gw_[r * 256 + h * 64 + lane];
    const float bias = gb[h * 64 + lane];
    float st = 0.f;
    for (int t = 0; t < S; ++t) {
        const size_t row = (size_t)b * S + t;
        float z = bias;
#pragma unroll
        for (int r = 0; r < 16; ++r) z += CG[row * 16 + r] * wcol[r];
        const float ls = fminf(z, 0.f) - log1pf(expf(-fabsf(z)));
        const float dec = expf(ls / 16.f);
        st = dec * st + bf2f(CK[row * 256 + h * 64 + lane]) * bf2f(CV[row * 256 + h * 64 + e]);
        const float o = wave_sum(bf2f(CQ[row * 256 + h * 64 + lane]) * 0.125f * st);
        if (lane == 0) graw[row * 256 + h * 64 + e] = o;
    }
}
__global__ void gla_post_kernel(const float* graw, const bf16* CR, const float* gn, bf16* concat) {
    const int gw = blockIdx.x * 4 + (threadIdx.x >> 6), lane = threadIdx.x & 63;
    const int h = gw & 3, row = gw >> 2;
    const float v = graw[(size_t)row * 256 + h * 64 + lane];
    const float ss = wave_sum(v * v);
    const float y = v * rsqrtf(ss / 64.f + EPS) * gn[lane];
    concat[(size_t)row * D + 768 + h * 64 + lane] = (bf16)f2bf(y * silu_f(bf2f(CR[(size_t)row * 256 + h * 64 + lane])));
}
}

#ifndef FAST_MIXIN
#define FAST_MIXIN 1
#endif
static void launch_fwd(Args a, int lo, int hi, hipStream_t stream) {
    a.ph_lo = lo; a.ph_hi = hi;
    hipLaunchKernelGGL(fwd, dim3(GRID), dim3(NTHREADS), LDS_BYTES, stream, a);
}
extern "C" void kernel_launch(void* const* d_in, const int* in_sizes, int n_in, void* d_out, int out_size, void* d_ws, size_t ws_size, hipStream_t stream) {
    static int ready = 0;
    if (!ready) {
        if (n_in != 23 || ws_size < WS_END || out_size != M * D) { fprintf(stderr, "kernel_launch: unexpected shapes (n_in %d ws %zu out %d)\n", n_in, ws_size, out_size); ready = -1; return; }
        if (hipFuncSetAttribute((const void*)fwd, hipFuncAttributeMaxDynamicSharedMemorySize, LDS_BYTES) != hipSuccess) { fprintf(stderr, "kernel_launch: hipFuncSetAttribute failed\n"); ready = -1; return; }
        { int dev = 0, cus = 0, per_cu = 0; (void)hipGetDevice(&dev); (void)hipDeviceGetAttribute(&cus, hipDeviceAttributeMultiprocessorCount, dev);
          (void)hipOccupancyMaxActiveBlocksPerMultiprocessor(&per_cu, (const void*)fwd, NTHREADS, LDS_BYTES);
          if (cus * per_cu < GRID) { fprintf(stderr, "kernel_launch: grid of %d workgroups is not co-resident (CUs %d x %d per CU)\n", GRID, cus, per_cu); ready = -1; return; } }
        ready = 1;
    }
    if (ready < 0) return;
    Args a{};
    for (int i = 0; i < 23; ++i) a.in[i] = d_in[i];
    a.out = (float*)d_out; a.ws = (unsigned char*)d_ws;
    unsigned char* ws = (unsigned char*)d_ws;
    (void)hipMemsetAsync(ws + WS_CTL, 0, CTL_ZERO_BYTES, stream);
#ifndef ONE_LAUNCH
#define ONE_LAUNCH 1
#endif
#if ONE_LAUNCH
    a.ph_lo = 0; a.ph_hi = NPHASES;
    { void* kargs[] = {&a};
      hipError_t e = hipLaunchCooperativeKernel((const void*)fwd, dim3(GRID), dim3(NTHREADS), kargs, LDS_BYTES, stream);
      if (e != hipSuccess) fprintf(stderr, "kernel_launch: cooperative launch failed: %s\n", hipGetErrorString(e)); }
    return;
#endif
    launch_fwd(a, 0, 1, stream);
    launch_fwd(a, 1, 2, stream);
    float* X = (float*)d_out;
    const float* MOD = (const float*)(ws + WS_MOD); const float* GP = (const float*)(ws + WS_GP); float* ROWSS = (float*)(ws + WS_ROWSS);
    bf16* XS = (bf16*)(ws + WS_XS); bf16* CONCAT = (bf16*)(ws + WS_CONCAT);
    ProjDst pd{(bf16*)(ws + WS_QB), (bf16*)(ws + WS_KB), (bf16*)(ws + WS_VB), (bf16*)(ws + WS_KV), (bf16*)(ws + WS_CQ), (bf16*)(ws + WS_CK), (bf16*)(ws + WS_CV), (bf16*)(ws + WS_CR), (float*)(ws + WS_CG)};
    for (int l = 0; l < DEPTH; ++l) {
        const int base = 2 + 9 * l;
        const float* mod = MOD + (size_t)l * NB * MODW;
        launch_fwd(a, base + 0, base + 1, stream);
        launch_fwd(a, base + 1, base + 2, stream);
        float* KMEAN = (float*)(ws + WS_KMEAN) + (size_t)l * 32768;
#if FAST_MIXIN
        launch_fwd(a, base + 2, base + 3, stream);
        cg_kernel<<<M / 4, 256, 0, stream>>>(XS, ROWSS + (size_t)(3 * l + 1) * M, (const bf16*)(ws + WS_WCG) + (size_t)l * 16 * D, (const float*)(ws + WS_SW) + (size_t)l * SWL + SW_CG, pd.CG);
#else
        norm_mod_kernel<<<M / 4, 256, 0, stream>>>(X, (const float*)d_in[8] + l * D, mod + 3 * D, mod + 4 * D, XS);
        gemm_kernel<0><<<dim3((INW + 63) / 64, M / 64), 256, 0, stream>>>(XS, (const float*)d_in[9] + (size_t)l * D * INW, nullptr, INW, D, INW, nullptr, 0.f, pd);
        glu_kernel<<<M * 256 / 256, 256, 0, stream>>>(pd.BU, (bf16*)(ws + WS_HGLU));
        qk_prep_kernel<<<M * 16 / 4, 256, 0, stream>>>(pd.QB, pd.KB, (const int*)d_in[2], (const float*)d_in[10] + l * 64, (const float*)d_in[11] + l * 64);
        kmean_kernel<<<NB * 8 * 16 * 64 / 256, 256, 0, stream>>>(pd.KB, KMEAN);
#endif
#if !FAST_ATTN
        attn_kernel<<<M * 8 / 4, 256, 0, stream>>>(pd.QB, pd.KB, pd.VB, KMEAN, CONCAT);
#endif
#ifndef FAST_MIXERS
#define FAST_MIXERS 1
#endif
#if FAST_MIXERS
        launch_fwd(a, base + 3, base + 4, stream);
        launch_fwd(a, base + 4, base + 5, stream);
        launch_fwd(a, base + 5, base + 6, stream);
        launch_fwd(a, base + 6, base + 7, stream);
#else
        conv_kernel<<<M * 4 / 4, 256, 0, stream>>>((const bf16*)(ws + WS_HGLU), (const float*)d_in[12] + (size_t)l * 31 * 256, (const float*)d_in[13] + l * 256, (const float*)d_in[14] + l * 256, (const float*)d_in[15] + l * 256, CONCAT);
        gla_kernel<<<NB * 4 * 64 / 4, 256, 0, stream>>>(pd.CG, pd.CQ, pd.CK, pd.CV, (const float*)d_in[16] + (size_t)l * 16 * 256, (const float*)d_in[17] + l * 256, (float*)(ws + WS_KV));
        gla_post_kernel<<<M * 4 / 4, 256, 0, stream>>>((const float*)(ws + WS_KV), pd.CR, (const float*)d_in[18] + l * 64, CONCAT);
        gemm_kernel<2><<<dim3(D / 64, M / 64), 256, 0, stream>>>(CONCAT, (const float*)d_in[19] + (size_t)l * D * D, X, D, D, D, mod + 5 * D, 1.0f, pd);
        norm_xs_kernel<<<M / 4, 256, 0, stream>>>(X, GP + (size_t)(3 * l + 2) * NB * D, XS, ROWSS + (size_t)(3 * l + 2) * M);
#endif
        launch_fwd(a, base + 7, base + 8, stream);
        launch_fwd(a, base + 8, base + 9, stream);
    }
}
```

```cpp
#include <hip/hip_runtime.h>
#include <cstdio>
#include <cstdint>
#include <cmath>
#include <hip/hip_bf16.h>
#include <hip/hip_cooperative_groups.h>
namespace {
constexpr int D = 1024, NB = 4, S = 4096, M = NB * S, DEPTH = 2;
constexpr int DFF = 2816, INW = 3088, NMOD = 9, MODW = NMOD * D;
constexpr int OFF_Q = 0, OFF_K = 512, OFF_V = 1024, OFF_BU = 1536, OFF_CQ = 2048, OFF_CK = 2304, OFF_CV = 2560, OFF_CR = 2816, OFF_CG = 3072;
constexpr float EPS = 1e-6f;
constexpr float QSCALE = 0.125f * 1.4426950408889634f;
constexpr int NWAVES = 8, NTHREADS = 512, GRID = 256;
constexpr int LDS_BYTES = 147456;

constexpr size_t MiB = 1u << 20;
constexpr size_t WS_CTL = 0, CTL_ZERO_BYTES = 1 * MiB;
constexpr size_t WS_MOD = 1 * MiB;
constexpr size_t WS_GP = 1 * MiB + 512 * 1024;
constexpr size_t WS_SW = 2 * MiB;
constexpr int SW_F1 = 0, SW_MIX = 4 * 5632, SW_CG = SW_MIX + 4 * 3072, SW_F2 = SW_CG + 64, SWL = SW_F2 + 4 * 5632;
constexpr size_t WS_ROWSS = 3 * MiB;
constexpr size_t WS_KMEAN = 3 * MiB + 512 * 1024;
constexpr size_t WS_ROPEC = 4 * MiB, WS_ROPES = 6 * MiB;
constexpr size_t WS_CG = 8 * MiB;
constexpr size_t WS_DEC = 9 * MiB;
constexpr size_t WS_WCG = 10 * MiB;
constexpr size_t WS_W = 16 * MiB, W_LAYER = 41 * MiB;
constexpr size_t W_F1IN = 0, W_F1OUT = 11 * MiB, W_MIXIN = 16 * MiB + 512 * 1024, W_MIXOUT = 22 * MiB + 512 * 1024, W_F2IN = 24 * MiB + 512 * 1024, W_F2OUT = 35 * MiB + 512 * 1024;
constexpr size_t WS_XS = 100 * MiB;
constexpr size_t WS_HMID = 132 * MiB;
constexpr size_t WS_QB = 132 * MiB, WS_KB = 148 * MiB, WS_VB = 164 * MiB, WS_HGLU = 180 * MiB, WS_CQ = 188 * MiB, WS_CK = 196 * MiB, WS_CV = 204 * MiB, WS_CR = 212 * MiB;
constexpr size_t WS_CONCAT = 220 * MiB;
constexpr size_t WS_KV = 252 * MiB;
constexpr size_t WS_SPT = 268 * MiB;
constexpr size_t WS_END = 276 * MiB;


template <int CTRL> __device__ __forceinline__ float dpp_f(float v) { return __builtin_bit_cast(float, __builtin_amdgcn_update_dpp(0, __builtin_bit_cast(int, v), CTRL, 0xF, 0xF, true)); }
__device__ __forceinline__ float add_x1(float v) { return v + dpp_f<0xB1>(v); }
__device__ __forceinline__ float add_x2(float v) { return v + dpp_f<0x4E>(v); }
__device__ __forceinline__ float row16_sum(float v) { v = add_x1(v); v = add_x2(v); v += dpp_f<0x141>(v); v += dpp_f<0x140>(v); return v; }
__device__ __forceinline__ float add_x16(float v) { const unsigned u = __builtin_bit_cast(unsigned, v); auto r = __builtin_amdgcn_permlane16_swap(u, u, false, false); return __builtin_bit_cast(float, (unsigned)r[0]) + __builtin_bit_cast(float, (unsigned)r[1]); }
__device__ __forceinline__ float add_x32(float v) { const unsigned u = __builtin_bit_cast(unsigned, v); auto r = __builtin_amdgcn_permlane32_swap(u, u, false, false); return __builtin_bit_cast(float, (unsigned)r[0]) + __builtin_bit_cast(float, (unsigned)r[1]); }
}
namespace pg8 {
#define PG8_LAS __attribute__((address_space(3)))
typedef unsigned short bf16_t;
typedef short bf16x8 __attribute__((ext_vector_type(8)));
typedef float f32x4 __attribute__((ext_vector_type(4)));
typedef unsigned u32x4 __attribute__((ext_vector_type(4)));
constexpr int BM = 256, BK = 64, HALF = 128, HTB = HALF * BK * 2  , STAGE_BYTES = 8 * HTB, NXCD = 8, WGM = 8;

__host__ __device__ __forceinline__ int lds_byte(int r, int c) { const int st = (r >> 4) * 2 + (c >> 5), rr = r & 15, cc = c & 31, ob = rr * 64 + cc * 2; return st * 1024 + (ob ^ (((ob >> 9) & 1) << 5)); }
__host__ __device__ __forceinline__ void stage_rc(int b, int& R, int& C) { const int st = b / 1024, sb = b % 1024, swz = sb ^ (((sb >> 9) & 1) << 5); R = (st >> 1) * 16 + swz / 64; C = (st & 1) * 32 + (swz % 64) / 2; }
__host__ __device__ __forceinline__ int perm32(int rho) { const int n = rho >> 4, i = rho & 15; return 8 * (i >> 2) + 4 * n + (i & 3); }

struct Unit { int pm, pn; };
struct Gemm { const bf16_t* A; const bf16_t* Bt; int M, N, K; };

struct StaticOrder {
    int nM, nN, nwg, G, c;
    __host__ __device__ void init(int M, int N, int G_, int c_) { nM = M / BM; nN = N / BM; nwg = nM * nN; G = G_; c = c_; }
    __host__ __device__ bool next(int i, Unit& u) const {
        const long L = (long)i * G + c; if (L >= nwg) return false;
        int wgid = (int)L; { const int q = nwg / NXCD, r = nwg % NXCD, xcd = wgid % NXCD, off = wgid / NXCD; wgid = (xcd < r ? xcd * (q + 1) : r * (q + 1) + (xcd - r) * q) + off; }
        const int nig = WGM * nN, gid = wgid / nig, fm = gid * WGM, gsz = (nM - fm) < WGM ? (nM - fm) : WGM;
        u.pm = fm + ((wgid % nig) % gsz); u.pn = (wgid % nig) / gsz; return true;
    }
    __device__ __forceinline__ void a_ready(const Unit&) const {}
    __device__ __forceinline__ void done(const Unit&) const {}
};

__device__ __forceinline__ unsigned cvt_pk_bf16(float lo, float hi) { unsigned r; asm volatile("v_cvt_pk_bf16_f32 %0, %1, %2" : "=v"(r) : "v"(lo), "v"(hi)); return r; }

typedef unsigned u32x2 __attribute__((ext_vector_type(2)));
constexpr float EPI_EPS = 1e-6f;
__device__ __forceinline__ float sigmoid_fast(float v) { return __builtin_amdgcn_rcpf(1.f + __builtin_amdgcn_exp2f(-1.4426950408889634f * v)); }
__device__ __forceinline__ u32x4 pack8(const f32x4 a, const f32x4 b) { u32x4 w; w.x = cvt_pk_bf16(a[0], a[1]); w.y = cvt_pk_bf16(a[2], a[3]); w.z = cvt_pk_bf16(b[0], b[1]); w.w = cvt_pk_bf16(b[2], b[3]); return w; }

struct EpiSwiGLU {
    static constexpr bool PERM = true, AFTER_DRAIN = false;
    unsigned char* ws; int st, swoff;
    __device__ __forceinline__ void operator()(const f32x4 (&acc)[2][2][4][2], const Unit& u, int wr, int wc, int fr_in, int fq_in) const {
        int fr = fr_in, fq = fq_in; asm volatile("" : "+v"(fr), "+v"(fq));
        const int b = u.pm >> 4; constexpr int nbt = 5632, ldh = 2816;
        bf16_t* H = (bf16_t*)(ws + WS_HMID); const float* rowss = (const float*)(ws + WS_ROWSS) + (size_t)st * 16384;
        const float* sw = (const float*)(ws + WS_SW) + swoff + (size_t)b * nbt + u.pn * BM + wc * 32 + 8 * fq;
        const f32x4 sa0 = *(const f32x4*)sw, sa1 = *(const f32x4*)(sw + 4), sb0 = *(const f32x4*)(sw + HALF), sb1 = *(const f32x4*)(sw + HALF + 4);
        const int colh = u.pn * HALF + wc * 32 + 8 * fq;
#pragma unroll
        for (int ai = 0; ai < 2; ++ai)
#pragma unroll
            for (int m = 0; m < 4; ++m) {
                const int row = u.pm * BM + ai * HALF + wr * 64 + m * 16 + fr;
                const float r = __builtin_amdgcn_rsqf(rowss[row] * (1.0f / 1024.0f) + EPI_EPS);
                f32x4 a0 = acc[ai][0][m][0] * r + sa0, a1 = acc[ai][0][m][1] * r + sa1, b0 = acc[ai][1][m][0] * r + sb0, b1 = acc[ai][1][m][1] * r + sb1;
                f32x4 o0, o1;
#pragma unroll
                for (int j = 0; j < 4; ++j) { o0[j] = a0[j] * sigmoid_fast(a0[j]) * b0[j]; o1[j] = a1[j] * sigmoid_fast(a1[j]) * b1[j]; }
                *(u32x4*)(H + (size_t)row * ldh + colh) = pack8(o0, o1);
            }
    }
};

struct EpiResid {
    static constexpr bool PERM = true, AFTER_DRAIN = false;
    const float* xin; float* xout; unsigned char* ws; int gate_off; float coef; int nst;
    __device__ __forceinline__ void operator()(const f32x4 (&acc)[2][2][4][2], const Unit& u, int wr, int wc, int fr_in, int fq_in) const {
        int fr = fr_in, fq = fq_in; asm volatile("" : "+v"(fr), "+v"(fq));
        const int b = u.pm >> 4, col0 = u.pn * BM + wc * 32 + 8 * fq;
        const float* gate = (const float*)(ws + WS_MOD) + gate_off; const bool has_next = nst >= 0;
        const float* gp = (const float*)(ws + WS_GP) + (size_t)(has_next ? nst : 0) * 4096; float* rowss_next = (float*)(ws + WS_ROWSS) + (size_t)(has_next ? nst : 0) * 16384;
        bf16_t* XS = (bf16_t*)(ws + WS_XS); const f32x4 cv = {coef, coef, coef, coef};
        f32x4 g[2][2], p[2][2];
#pragma unroll
        for (int bj = 0; bj < 2; ++bj)
#pragma unroll
            for (int n = 0; n < 2; ++n) { g[bj][n] = *(const f32x4*)(gate + (size_t)b * 9216 + col0 + bj * HALF + 4 * n) * cv;
                p[bj][n] = *(const f32x4*)(gp + (size_t)b * 1024 + col0 + bj * HALF + 4 * n); }
#pragma unroll
        for (int ai = 0; ai < 2; ++ai)
#pragma unroll
        for (int mh = 0; mh < 2; ++mh) {
            f32x4 xo[4][2][2];
#pragma unroll
            for (int m = 2 * mh; m < 2 * mh + 2; ++m) { const size_t off = (size_t)(u.pm * BM + ai * HALF + wr * 64 + m * 16 + fr) * 1024 + col0;
#pragma unroll
                for (int bj = 0; bj < 2; ++bj)
#pragma unroll
                    for (int n = 0; n < 2; ++n) xo[m][bj][n] = *(const f32x4*)(xin + off + bj * HALF + 4 * n); }
#pragma unroll
            for (int m = 2 * mh; m < 2 * mh + 2; ++m) {
                const int row = u.pm * BM + ai * HALF + wr * 64 + m * 16 + fr;
                const size_t off = (size_t)row * 1024 + col0;
                float ssq = 0.f;
#pragma unroll
                for (int bj = 0; bj < 2; ++bj) {
                    f32x4 xn[2];
#pragma unroll
                    for (int n = 0; n < 2; ++n) { xn[n] = xo[m][bj][n] + g[bj][n] * acc[ai][bj][m][n];
                        *(f32x4*)(xout + off + bj * HALF + 4 * n) = xn[n]; ssq += (xn[n][0] * xn[n][0] + xn[n][1] * xn[n][1]) + (xn[n][2] * xn[n][2] + xn[n][3] * xn[n][3]); }
                    if (has_next) *(u32x4*)(XS + off + bj * HALF) = pack8(xn[0] * p[bj][0], xn[1] * p[bj][1]);
                }
                if (has_next) { ssq = add_x16(ssq); ssq = add_x32(ssq); if (fq == 0) atomicAdd(rowss_next + row, ssq); }
            }
            asm volatile("" ::: "memory");
        }
    }
};

struct EpiMixIn {
    static constexpr bool PERM = true, AFTER_DRAIN = false;
    unsigned char* ws; const float *qn, *kn; int l; float qscale;
    __device__ __forceinline__ void operator()(const f32x4 (&acc)[2][2][4][2], const Unit& u, int wr, int wc, int fr_in, int fq_in) const {
        int fr = fr_in, fq = fq_in; asm volatile("" : "+v"(fr), "+v"(fq));
        const int b = u.pm >> 4, blk = u.pm & 15, pn = u.pn;
        const float* rowss = (const float*)(ws + WS_ROWSS) + (size_t)(3 * l + 1) * 16384;
        const float* sw = (const float*)(ws + WS_SW) + (size_t)l * SWL + SW_MIX + (size_t)b * 3072 + pn * BM + wc * 32 + 8 * fq;
        f32x4 s[2][2];
#pragma unroll
        for (int bj = 0; bj < 2; ++bj)
#pragma unroll
            for (int n = 0; n < 2; ++n) s[bj][n] = *(const f32x4*)(sw + bj * HALF + 4 * n);
        if (pn < 4) {
            const bool isk = pn >= 2; const int head = 4 * (pn & 1) + wc;
            const float* gn = isk ? kn : qn;
            f32x4 gl[2], gh[2], ks[2][2];
#pragma unroll
            for (int n = 0; n < 2; ++n) { gl[n] = *(const f32x4*)(gn + 8 * fq + 4 * n); gh[n] = *(const f32x4*)(gn + 32 + 8 * fq + 4 * n); ks[0][n] = (f32x4){0.f, 0.f, 0.f, 0.f}; ks[1][n] = (f32x4){0.f, 0.f, 0.f, 0.f}; }
            bf16_t* dstb = (bf16_t*)(ws + (isk ? WS_KB : WS_QB)) + head * 64 + 8 * fq;
            const float* ropec = (const float*)(ws + WS_ROPEC); const float* ropes = (const float*)(ws + WS_ROPES);
            const float osc = isk ? 1.0f : qscale;
#pragma unroll
            for (int ai = 0; ai < 2; ++ai)
#pragma unroll
            for (int mh = 0; mh < 2; ++mh) {
                f32x4 rc[4][2], rs[4][2]; float rr[4];
#pragma unroll
                for (int m = 2 * mh; m < 2 * mh + 2; ++m) { const int row = u.pm * BM + ai * HALF + wr * 64 + m * 16 + fr; rr[m] = rowss[row];
#pragma unroll
                    for (int n = 0; n < 2; ++n) { rc[m][n] = *(const f32x4*)(ropec + (size_t)row * 32 + 8 * fq + 4 * n); rs[m][n] = *(const f32x4*)(ropes + (size_t)row * 32 + 8 * fq + 4 * n); } }
#pragma unroll
                for (int m = 2 * mh; m < 2 * mh + 2; ++m) {
                    const int row = u.pm * BM + ai * HALF + wr * 64 + m * 16 + fr;
                    const float r = __builtin_amdgcn_rsqf(rr[m] * (1.0f / 1024.0f) + EPI_EPS);
                    f32x4 v[2][2]; float ss = 0.f;
#pragma unroll
                    for (int bj = 0; bj < 2; ++bj)
#pragma unroll
                        for (int n = 0; n < 2; ++n) { v[bj][n] = acc[ai][bj][m][n] * r + s[bj][n]; ss += (v[bj][n][0] * v[bj][n][0] + v[bj][n][1] * v[bj][n][1]) + (v[bj][n][2] * v[bj][n][2] + v[bj][n][3] * v[bj][n][3]); }
                    ss = add_x16(ss); ss = add_x32(ss);
                    const float rn = __builtin_amdgcn_rsqf(ss * (1.0f / 64.0f) + EPI_EPS);
                    f32x4 ol[2], oh[2];
#pragma unroll
                    for (int n = 0; n < 2; ++n) { const f32x4 cs = rc[m][n], sn = rs[m][n];
                        const f32x4 yl = v[0][n] * rn * gl[n], yh = v[1][n] * rn * gh[n];
                        ol[n] = (yl * cs - yh * sn) * osc; oh[n] = (yh * cs + yl * sn) * osc;
                        ks[0][n] += ol[n]; ks[1][n] += oh[n]; }
                    *(u32x4*)(dstb + (size_t)row * 512) = pack8(ol[0], ol[1]);
                    *(u32x4*)(dstb + (size_t)row * 512 + 32) = pack8(oh[0], oh[1]);
                }
                asm volatile("" ::: "memory");
            }
            if (isk) {
                float* km = (float*)(ws + WS_KMEAN) + (size_t)l * 32768 + ((size_t)(b * 8 + head) * 16 + blk) * 64 + 8 * fq;
#pragma unroll
                for (int bj = 0; bj < 2; ++bj)
#pragma unroll
                    for (int n = 0; n < 2; ++n)
#pragma unroll
                        for (int j = 0; j < 4; ++j) { float t = ks[bj][n][j]; t = row16_sum(t);
                            if (fr == 0) atomicAdd(km + 32 * bj + 4 * n + j, t * (1.0f / 256.0f)); }
            }
        } else if (pn == 6 || pn == 7) {
            const int colg = (pn - 6) * HALF + wc * 32 + 8 * fq;
#pragma unroll
            for (int ai = 0; ai < 2; ++ai)
#pragma unroll
                for (int m = 0; m < 4; ++m) {
                    const int row = u.pm * BM + ai * HALF + wr * 64 + m * 16 + fr;
                    const float r = __builtin_amdgcn_rsqf(rowss[row] * (1.0f / 1024.0f) + EPI_EPS);
                    f32x4 o[2];
#pragma unroll
                    for (int n = 0; n < 2; ++n) { const f32x4 a = acc[ai][0][m][n] * r + s[0][n], g = acc[ai][1][m][n] * r + s[1][n];
#pragma unroll
                        for (int j = 0; j < 4; ++j) o[n][j] = a[j] * sigmoid_fast(g[j]); }
                    *(u32x4*)((bf16_t*)(ws + WS_HGLU) + (size_t)row * 256 + colg) = pack8(o[0], o[1]);
                }
        } else {
            bf16_t* dst; int ld;
            if (pn < 6) { dst = (bf16_t*)(ws + WS_VB) + (pn - 4) * BM; ld = 512; } else { dst = (bf16_t*)(ws + WS_CQ + (size_t)(pn - 8) * (8u << 20)); ld = 256; }
            dst += wc * 32 + 8 * fq;
#pragma unroll
            for (int ai = 0; ai < 2; ++ai)
#pragma unroll
                for (int m = 0; m < 4; ++m) {
                    const int row = u.pm * BM + ai * HALF + wr * 64 + m * 16 + fr;
                    const float r = __builtin_amdgcn_rsqf(rowss[row] * (1.0f / 1024.0f) + EPI_EPS);
#pragma unroll
                    for (int bj = 0; bj < 2; ++bj) *(u32x4*)(dst + (size_t)row * ld + bj * HALF) = pack8(acc[ai][bj][m][0] * r + s[bj][0], acc[ai][bj][m][1] * r + s[bj][1]);
                }
        }
    }
};


template <class Epi, class Sched, bool ALIGN_EPI = false, bool SP2 = false>
__device__ __forceinline__ void gemm_phase(PG8_LAS unsigned char* lds, const Gemm g, const Sched& S, const Epi& E, const int tid_in) {
    const int tid = tid_in, wid = __builtin_amdgcn_readfirstlane(tid >> 6), lane = tid & 63, wr = wid >> 2, wc = wid & 3, fr = lane & 15, fq = lane >> 4;
    const int K = g.K, nt = K / BK;
    unsigned voffA[2], voffB[2];
#pragma unroll
    for (int i = 0; i < 2; ++i) { int R, C; stage_rc(tid * 16 + i * 8192, R, C); const int Rb = Epi::PERM ? ((R & ~31) + perm32(R & 31)) : R;
        voffA[i] = (unsigned)(R * K + C) * 2u; voffB[i] = (unsigned)(Rb * K + C) * 2u; }
    const size_t kstep = (size_t)(BK * 2);
    const size_t hstep = (size_t)HALF * K * 2;
    const size_t tstep = 2 * hstep;
    const unsigned ldsw = (unsigned)wid * 1024u;
    const int aoff = lds_byte(wr * 64 + fr, fq * 8), boff = lds_byte(wc * 32 + fr, fq * 8);
#define PG8_SA(b, h) (((b) * 2 + (h)) * HTB)
#define PG8_SB(b, h) ((4 + (b) * 2 + (h)) * HTB)
#define PG8_STAGE(bufoff, gbase, voff) do { _Pragma("unroll") for (int _i = 0; _i < 2; ++_i) \
        __builtin_amdgcn_global_load_lds((const unsigned*)((const char*)(gbase) + (voff)[_i]), (PG8_LAS unsigned*)(lds + (bufoff) + ldsw + _i * 8192), 16, 0, 0); } while (0)
#define PG8_LDA(dst, b, h) do { _Pragma("unroll") for (int m = 0; m < 4; ++m) _Pragma("unroll") for (int k = 0; k < 2; ++k) dst[m][k] = *(const PG8_LAS bf16x8*)(lds + PG8_SA(b, h) + aoff + m * 2048 + k * 1024); } while (0)
#define PG8_LDB(dst, b, h) do { _Pragma("unroll") for (int n = 0; n < 2; ++n) _Pragma("unroll") for (int k = 0; k < 2; ++k) dst[n][k] = *(const PG8_LAS bf16x8*)(lds + PG8_SB(b, h) + boff + n * 2048 + k * 1024); } while (0)
#define PG8_MMA(ai, bj, At, Bt) do { __builtin_amdgcn_s_setprio(1); _Pragma("unroll") for (int m = 0; m < 4; ++m) _Pragma("unroll") for (int n = 0; n < 2; ++n) _Pragma("unroll") for (int k = 0; k < 2; ++k) \
        acc[ai][bj][m][n] = __builtin_amdgcn_mfma_f32_16x16x32_bf16(Bt[n][k], At[m][k], acc[ai][bj][m][n], 0, 0, 0); __builtin_amdgcn_s_setprio(0); } while (0)
#define PG8_WAIT_V(n) asm volatile("s_waitcnt vmcnt(" #n ")" ::: "memory")
#define PG8_WAIT_L(n) asm volatile("s_waitcnt lgkmcnt(" #n ")" ::: "memory")
#define PG8_BAR __builtin_amdgcn_s_barrier()
#define PG8_SCHED __builtin_amdgcn_sched_barrier(0)
    Unit cur, nxt; int ui = 0;
    if (!S.next(0, cur)) return;
    f32x4 acc[2][2][4][2];
#pragma unroll
    for (int a = 0; a < 2; ++a)
#pragma unroll
        for (int b = 0; b < 2; ++b)
#pragma unroll
            for (int m = 0; m < 4; ++m)
#pragma unroll
                for (int n = 0; n < 2; ++n) acc[a][b][m][n] = (f32x4){0.f, 0.f, 0.f, 0.f};
    bf16x8 At[4][2], B0[2][2], B1[2][2];
    const char* cA = (const char*)g.A + (size_t)cur.pm * tstep; const char* cB = (const char*)g.Bt + (size_t)cur.pn * tstep;
    S.a_ready(cur);
    if constexpr (SP2) {
        PG8_STAGE(PG8_SB(0, 0), cB, voffB); PG8_STAGE(PG8_SB(0, 1), cB + hstep, voffB); PG8_STAGE(PG8_SA(0, 0), cA, voffA); PG8_STAGE(PG8_SA(0, 1), cA + hstep, voffA);
        if (wr == 1) PG8_BAR;
        PG8_WAIT_V(2); PG8_BAR;
        PG8_STAGE(PG8_SB(1, 0), cB + kstep, voffB); PG8_STAGE(PG8_SA(1, 0), cA + kstep, voffA); PG8_STAGE(PG8_SB(1, 1), cB + hstep + kstep, voffB);
        PG8_WAIT_V(6); PG8_BAR;
    } else {
        PG8_STAGE(PG8_SB(0, 0), cB, voffB); PG8_STAGE(PG8_SA(0, 0), cA, voffA); PG8_STAGE(PG8_SB(0, 1), cB + hstep, voffB); PG8_STAGE(PG8_SA(0, 1), cA + hstep, voffA);
        if (wr == 1) PG8_BAR;
        PG8_WAIT_V(4); PG8_BAR;
        PG8_STAGE(PG8_SB(1, 0), cB + kstep, voffB); PG8_STAGE(PG8_SA(1, 0), cA + kstep, voffA); PG8_STAGE(PG8_SB(1, 1), cB + hstep + kstep, voffB);
        PG8_WAIT_V(6); PG8_BAR;
    }
    for (;;) {
        const bool has_next = S.next(ui + 1, nxt);
        const char* nA = has_next ? (const char*)g.A + (size_t)nxt.pm * tstep : cA; const char* nB = has_next ? (const char*)g.Bt + (size_t)nxt.pn * tstep : cB;
        for (int t = 0; t < nt; t += 2) {
            const bool last = (t == nt - 2);
            const char* a1 = cA + (size_t)(t + 1) * kstep;
            const char* a2 = last ? nA : cA + (size_t)(t + 2) * kstep; const char* b2 = last ? nB : cB + (size_t)(t + 2) * kstep;
            const char* a3 = a2 + kstep; const char* b3 = b2 + kstep;
            if (last && has_next) S.a_ready(nxt);
            if constexpr (SP2) {
            PG8_LDB(B0, 0, 0); PG8_LDB(B1, 0, 1); PG8_SCHED; PG8_LDA(At, 0, 0); PG8_STAGE(PG8_SA(1, 1), a1 + hstep, voffA);
            PG8_WAIT_V(8); PG8_WAIT_L(0); PG8_BAR; PG8_MMA(0, 0, At, B0); PG8_MMA(0, 1, At, B1); PG8_BAR; PG8_SCHED;
            PG8_LDA(At, 0, 1); PG8_STAGE(PG8_SB(0, 0), b2, voffB); PG8_STAGE(PG8_SB(0, 1), b2 + hstep, voffB); PG8_STAGE(PG8_SA(0, 0), a2, voffA);
            PG8_WAIT_V(8); PG8_WAIT_L(0); PG8_BAR; PG8_MMA(1, 0, At, B0); PG8_MMA(1, 1, At, B1); PG8_BAR; PG8_SCHED;
            PG8_LDB(B0, 1, 0); PG8_LDB(B1, 1, 1); PG8_SCHED; PG8_LDA(At, 1, 0); PG8_STAGE(PG8_SA(0, 1), a2 + hstep, voffA);
            PG8_WAIT_V(8); PG8_WAIT_L(0); PG8_BAR; PG8_MMA(0, 0, At, B0); PG8_MMA(0, 1, At, B1); PG8_BAR; PG8_SCHED;
            PG8_LDA(At, 1, 1); PG8_STAGE(PG8_SB(1, 0), b3, voffB); PG8_STAGE(PG8_SB(1, 1), b3 + hstep, voffB); PG8_STAGE(PG8_SA(1, 0), a3, voffA);
            PG8_WAIT_V(8); PG8_WAIT_L(0); PG8_BAR; PG8_MMA(1, 0, At, B0); PG8_MMA(1, 1, At, B1); PG8_BAR; PG8_SCHED;
            } else {
            PG8_LDB(B0, 0, 0); PG8_SCHED; PG8_LDA(At, 0, 0); PG8_STAGE(PG8_SA(1, 1), a1 + hstep, voffA);
            PG8_WAIT_L(8); PG8_BAR; PG8_WAIT_L(0); PG8_MMA(0, 0, At, B0); PG8_BAR; PG8_SCHED;
            PG8_LDB(B1, 0, 1); PG8_STAGE(PG8_SB(0, 0), b2, voffB);
            PG8_BAR; PG8_WAIT_L(0); PG8_MMA(0, 1, At, B1); PG8_BAR;
            PG8_LDA(At, 0, 1); PG8_STAGE(PG8_SA(0, 0), a2, voffA);
            PG8_BAR; PG8_WAIT_L(0); PG8_MMA(1, 0, At, B0); PG8_BAR; PG8_SCHED;
            PG8_STAGE(PG8_SB(0, 1), b2 + hstep, voffB);
            PG8_WAIT_V(6); PG8_BAR; PG8_MMA(1, 1, At, B1); PG8_BAR;
            PG8_LDB(B0, 1, 0); PG8_SCHED; PG8_LDA(At, 1, 0); PG8_STAGE(PG8_SA(0, 1), a2 + hstep, voffA);
            PG8_WAIT_L(8); PG8_BAR; PG8_WAIT_L(0); PG8_MMA(0, 0, At, B0); PG8_BAR; PG8_SCHED;
            PG8_LDB(B1, 1, 1); PG8_STAGE(PG8_SB(1, 0), b3, voffB);
            PG8_BAR; PG8_WAIT_L(0); PG8_MMA(0, 1, At, B1); PG8_BAR;
            PG8_LDA(At, 1, 1); PG8_STAGE(PG8_SA(1, 0), a3, voffA);
            PG8_BAR; PG8_WAIT_L(0); PG8_MMA(1, 0, At, B0); PG8_BAR; PG8_SCHED;
            PG8_STAGE(PG8_SB(1, 1), b3 + hstep, voffB);
            PG8_WAIT_V(6); PG8_BAR; PG8_MMA(1, 1, At, B1); PG8_BAR;
            }
        }
        if constexpr (ALIGN_EPI) { if (wr == 0) PG8_BAR; }
        if constexpr (!Epi::AFTER_DRAIN) { E(acc, cur, wr, wc, fr, fq); S.done(cur); }
        if (!has_next) break;
#pragma unroll
        for (int a = 0; a < 2; ++a)
#pragma unroll
            for (int b = 0; b < 2; ++b)
#pragma unroll
                for (int m = 0; m < 4; ++m)
#pragma unroll
                    for (int n = 0; n < 2; ++n) acc[a][b][m][n] = (f32x4){0.f, 0.f, 0.f, 0.f};
        cur = nxt; cA = nA; cB = nB; ++ui;
        if constexpr (ALIGN_EPI) { if (wr == 1) PG8_BAR; }
    }
    PG8_WAIT_V(0);
    if constexpr (!ALIGN_EPI) { if (wr == 0) PG8_BAR; }
    PG8_BAR;
    if constexpr (Epi::AFTER_DRAIN) { E.fused(acc, cur, wr, wc, fr, fq, lds, wid, lane); S.done(cur); }
#undef PG8_SA
#undef PG8_SB
#undef PG8_STAGE
#undef PG8_LDA
#undef PG8_LDB
#undef PG8_MMA
#undef PG8_WAIT_V
#undef PG8_WAIT_L
#undef PG8_BAR
#undef PG8_SCHED
}
}

namespace {
__constant__ float INV_FREQ[32] = {0x1.000000p+0f, 0x1.7ff222p-1f, 0x1.1feb34p-1f, 0x1.afd136p-2f, 0x1.43d136p-2f, 0x1.e5a84ap-3f, 0x1.6c310ep-3f, 0x1.111aeep-3f,
    0x1.99999ap-4f, 0x1.33281ap-4f, 0x1.ccab84p-5f, 0x1.59742ap-5f, 0x1.030dc6p-5f, 0x1.84869ep-6f, 0x1.235a72p-6f, 0x1.b4f7e4p-7f,
    0x1.47ae14p-7f, 0x1.eb7360p-8f, 0x1.708938p-8f, 0x1.145ceep-8f, 0x1.9e7c70p-9f, 0x1.36d21ap-9f, 0x1.d22a50p-10f, 0x1.5d931cp-10f,
    0x1.0624dep-10f, 0x1.892918p-11f, 0x1.26d42cp-11f, 0x1.ba2e4ep-12f, 0x1.4b96c0p-12f, 0x1.f1502ap-13f, 0x1.74eea6p-13f, 0x1.17a8e4p-13f};

#define LAS __attribute__((address_space(3)))
typedef unsigned short bf16;
typedef unsigned v4u __attribute__((ext_vector_type(4)));
typedef float f32x4 __attribute__((ext_vector_type(4)));
typedef float f32x2 __attribute__((ext_vector_type(2)));
#define LDS_WAIT() asm volatile("s_waitcnt lgkmcnt(0)" ::: "memory")

__device__ __forceinline__ unsigned f2bf(float f) { unsigned u = __builtin_bit_cast(unsigned, f); return (u + 0x7fffu + ((u >> 16) & 1u)) >> 16; }
__device__ __forceinline__ unsigned pk2(float lo, float hi) { return f2bf(lo) | (f2bf(hi) << 16); }
__device__ __forceinline__ float bf2f(bf16 v) { return __builtin_bit_cast(float, (unsigned)v << 16); }
__device__ __forceinline__ float wave_sum(float v) { return add_x32(add_x16(row16_sum(v))); }
__device__ __forceinline__ float wave_max(float v) {
#pragma unroll
    for (int o = 1; o < 64; o <<= 1) v = fmaxf(v, __shfl_xor(v, o));
    return v;
}
__device__ __forceinline__ float silu_f(float v) { return v / (1.f + expf(-v)); }
__device__ __forceinline__ float sigmoid_f(float v) { return 1.f / (1.f + expf(-v)); }

struct Args { const void* in[23]; float* out; unsigned char* ws; int ph_lo, ph_hi; };
typedef const __attribute__((address_space(4))) Args* ArgsP;

struct Frame {
    LAS unsigned char* lds;
    int tid, lane, wave, vcu, G;
    unsigned char* ws;
};

__device__ __forceinline__ void tr_item(const float* W, int ldw, int K, int src_c0, bf16* WT, int c0, int k0, LAS float* scr, int lane) {
    float tv[32];
#pragma unroll
    for (int i = 0; i < 32; ++i) tv[i] = W[(size_t)(k0 + 2 * i + (lane >> 5)) * ldw + src_c0 + (lane & 31)];
#pragma unroll
    for (int i = 0; i < 32; ++i) scr[(2 * i + (lane >> 5)) * 33 + (lane & 31)] = tv[i];
    LDS_WAIT(); asm volatile("" ::: "memory");
    const int c = lane & 7;
#pragma unroll
    for (int j = 0; j < 4; ++j) { const int n = (lane >> 3) + 8 * j; const LAS float* s = scr + (8 * c) * 33 + n;
        v4u o; o.x = pk2(s[0 * 33], s[1 * 33]); o.y = pk2(s[2 * 33], s[3 * 33]); o.z = pk2(s[4 * 33], s[5 * 33]); o.w = pk2(s[6 * 33], s[7 * 33]);
        *(v4u*)(WT + (size_t)(c0 + n) * K + k0 + 8 * c) = o; }
    LDS_WAIT(); asm volatile("" ::: "memory");
}
__device__ __forceinline__ int src_ffn_in(int c0) { return ((c0 >> 7) & 1) * DFF + (c0 >> 8) * 128 + (c0 & 127); }
__device__ __forceinline__ int src_mix_in(int c0) {
    const int pn = c0 >> 8, cl = c0 & 255;
    if (pn < 4) { const int head = 4 * (pn & 1) + ((cl >> 5) & 3), dim = 32 * (cl >> 7) + (cl & 31); return (pn < 2 ? OFF_Q : OFF_K) + 64 * head + dim; }
    if (pn < 6) return OFF_V + (c0 - 1024);
    if (pn < 8) return OFF_BU + (cl >> 7) * 256 + 128 * (pn - 6) + (cl & 127);
    return c0;
}
constexpr int IT_FIN = 16 * 176, IT_FOUT = 44 * 32, IT_MIN = 16 * 96, IT_MOUT = 16 * 32, IT_LAYER = 2 * IT_FIN + 2 * IT_FOUT + IT_MIN + IT_MOUT;

__device__ __forceinline__ void p0a(Frame& F, ArgsP a) {
    const float* cvec = (const float*)a->in[1]; const int* positions = (const int*)a->in[2];
    const float* ada_w = (const float*)a->in[3]; const float* ada_b = (const float*)a->in[4];
    float* MOD = (float*)(F.ws + WS_MOD);
    {
        LAS float* sc = (LAS float*)F.lds;
        LAS float* part = (LAS float*)(F.lds + 16384);
        for (int i = F.tid; i < 4096; i += NTHREADS) sc[i] = silu_f(cvec[i]);
        __syncthreads();
        for (int u = F.vcu; u < 2 * 72; u += GRID) {
            const int l = u / 72, ch = u % 72;
            const float* w = ada_w + (size_t)l * D * MODW + ch * 128 + 2 * F.lane;
            float acc[4][2] = {};
            const int kb = F.wave * 128;
#pragma unroll 32
            for (int k = 0; k < 128; ++k) { const f32x2 wv = *(const f32x2*)(w + (size_t)(kb + k) * MODW);
#pragma unroll
                for (int b = 0; b < 4; ++b) { const float s = sc[b * 1024 + kb + k]; acc[b][0] += s * wv.x; acc[b][1] += s * wv.y; } }
#pragma unroll
            for (int b = 0; b < 4; ++b) { part[(F.wave * 4 + b) * 128 + 2 * F.lane] = acc[b][0]; part[(F.wave * 4 + b) * 128 + 2 * F.lane + 1] = acc[b][1]; }
            __syncthreads();
            { const int b = F.tid >> 7, col = F.tid & 127; float s = 0.f;
#pragma unroll
                for (int w8 = 0; w8 < 8; ++w8) s += part[(w8 * 4 + b) * 128 + col];
                MOD[((size_t)l * NB + b) * MODW + ch * 128 + col] = s + ada_b[(size_t)l * MODW + ch * 128 + col]; }
            __syncthreads();
        }
        __syncthreads();
    }
    {
        LAS float* scr = (LAS float*)(F.lds + F.wave * 16384);
        const int gw = F.vcu * NWAVES + F.wave, NGW = GRID * NWAVES;
        for (int it = gw; it < DEPTH * IT_LAYER; it += NGW) {
            const int l = it / IT_LAYER; int r = it % IT_LAYER;
            unsigned char* wl = F.ws + WS_W + (size_t)l * W_LAYER;
            if (r < IT_FIN) { const int kb = r / 176, cb = r % 176; tr_item((const float*)a->in[6] + (size_t)l * D * 2 * DFF, 2 * DFF, D, src_ffn_in(32 * cb), (bf16*)(wl + W_F1IN), 32 * cb, 64 * kb, scr, F.lane); continue; } r -= IT_FIN;
            if (r < IT_FOUT) { const int kb = r / 32, cb = r % 32; tr_item((const float*)a->in[7] + (size_t)l * DFF * D, D, DFF, 32 * cb, (bf16*)(wl + W_F1OUT), 32 * cb, 64 * kb, scr, F.lane); continue; } r -= IT_FOUT;
            if (r < IT_MIN) { const int kb = r / 96, cb = r % 96; tr_item((const float*)a->in[9] + (size_t)l * D * INW, INW, D, src_mix_in(32 * cb), (bf16*)(wl + W_MIXIN), 32 * cb, 64 * kb, scr, F.lane); continue; } r -= IT_MIN;
            if (r < IT_MOUT) { const int kb = r / 32, cb = r % 32; tr_item((const float*)a->in[19] + (size_t)l * D * D, D, D, 32 * cb, (bf16*)(wl + W_MIXOUT), 32 * cb, 64 * kb, scr, F.lane); continue; } r -= IT_MOUT;
            if (r < IT_FIN) { const int kb = r / 176, cb = r % 176; tr_item((const float*)a->in[21] + (size_t)l * D * 2 * DFF, 2 * DFF, D, src_ffn_in(32 * cb), (bf16*)(wl + W_F2IN), 32 * cb, 64 * kb, scr, F.lane); continue; } r -= IT_FIN;
            { const int kb = r / 32, cb = r % 32; tr_item((const float*)a->in[22] + (size_t)l * DFF * D, D, DFF, 32 * cb, (bf16*)(wl + W_F2OUT), 32 * cb, 64 * kb, scr, F.lane); }
        }
    }
    const int gt = F.vcu * NTHREADS + F.tid, NGT = GRID * NTHREADS;
    { bf16* wcg = (bf16*)(F.ws + WS_WCG);
        for (int i = gt; i < DEPTH * 16 * 1024; i += NGT) { const int l = i >> 14, n = (i >> 10) & 15, k = i & 1023;
            wcg[i] = (bf16)f2bf(((const float*)a->in[9])[(size_t)l * D * INW + (size_t)k * INW + OFF_CG + n]); } }
    { float* rc = (float*)(F.ws + WS_ROPEC); float* rs = (float*)(F.ws + WS_ROPES);
        for (int i = gt; i < M * 32; i += NGT) { const float ang = (float)positions[i >> 5] * INV_FREQ[i & 31]; float sn, cs; sincosf(ang, &sn, &cs); rc[i] = cs; rs[i] = sn; } }
    { float* rss = (float*)(F.ws + WS_ROWSS) + M; for (int i = gt; i < 5 * M; i += NGT) rss[i] = 0.f;
      float* km = (float*)(F.ws + WS_KMEAN); for (int i = gt; i < 2 * 32768; i += NGT) km[i] = 0.f; }
}

__device__ __forceinline__ void p0b(Frame& F, ArgsP a) {
    const float* MOD = (const float*)(F.ws + WS_MOD);
    const int gt = F.vcu * NTHREADS + F.tid, NGT = GRID * NTHREADS;
    { float* GP = (float*)(F.ws + WS_GP);
        for (int i = gt; i < 6 * 4 * 1024; i += NGT) { const int s = i >> 12, b = (i >> 10) & 3, c = i & 1023, l = s / 3, j = s % 3;
            const float* nw = (j == 0 ? (const float*)a->in[5] : (j == 1 ? (const float*)a->in[8] : (const float*)a->in[20])) + l * D;
            GP[i] = nw[c] * (1.f + MOD[((size_t)l * NB + b) * MODW + (1 + 3 * j) * D + c]); } }
    const int gw = F.vcu * NWAVES + F.wave, NGW = GRID * NWAVES;
    for (int l = 0; l < DEPTH; ++l)
        for (int j = 0; j < 3; ++j) {
            float sh[4][16];
#pragma unroll
            for (int b = 0; b < 4; ++b)
#pragma unroll
                for (int q = 0; q < 4; ++q) { const f32x4 t = *(const f32x4*)(MOD + ((size_t)l * NB + b) * MODW + (3 * j) * D + 16 * F.lane + 4 * q); sh[b][4 * q] = t[0]; sh[b][4 * q + 1] = t[1]; sh[b][4 * q + 2] = t[2]; sh[b][4 * q + 3] = t[3]; }
            const int nrows = (j == 1) ? 3072 + 16 : 5632;
            const unsigned char* wl = F.ws + WS_W + (size_t)l * W_LAYER;
            float* sw = (float*)(F.ws + WS_SW) + (size_t)l * SWL;
            for (int r0 = gw; r0 < nrows; r0 += 4 * NGW) {
                v4u w0[4], w1[4];
#pragma unroll
                for (int q4 = 0; q4 < 4; ++q4) { const int r = r0 + q4 * NGW; const int rc = r < nrows ? r : r0;
                    const bf16* bt = (j == 0) ? (const bf16*)(wl + W_F1IN) + (size_t)rc * D : (j == 2) ? (const bf16*)(wl + W_F2IN) + (size_t)rc * D
                                   : (rc < 3072) ? (const bf16*)(wl + W_MIXIN) + (size_t)rc * D : (const bf16*)(F.ws + WS_WCG) + ((size_t)l * 16 + (rc - 3072)) * D;
                    w0[q4] = *(const v4u*)(bt + 16 * F.lane); w1[q4] = *(const v4u*)(bt + 16 * F.lane + 8); }
#pragma unroll
                for (int q4 = 0; q4 < 4; ++q4) { const int r = r0 + q4 * NGW;
                    float wf[16];
#pragma unroll
                    for (int q = 0; q < 4; ++q) { wf[2 * q] = __builtin_bit_cast(float, w0[q4][q] << 16); wf[2 * q + 1] = __builtin_bit_cast(float, w0[q4][q] & 0xffff0000u);
                        wf[8 + 2 * q] = __builtin_bit_cast(float, w1[q4][q] << 16); wf[8 + 2 * q + 1] = __builtin_bit_cast(float, w1[q4][q] & 0xffff0000u); }
                    float sb[4];
#pragma unroll
                    for (int b = 0; b < 4; ++b) { float s = 0.f;
#pragma unroll
                        for (int q = 0; q < 16; ++q) s += sh[b][q] * wf[q];
                        sb[b] = wave_sum(s); }
                    if (r < nrows && F.lane == 0) {
                        float* dst; int stride;
                        if (j == 0) { dst = sw + SW_F1 + r; stride = 5632; } else if (j == 2) { dst = sw + SW_F2 + r; stride = 5632; }
                        else if (r < 3072) { dst = sw + SW_MIX + r; stride = 3072; } else { dst = sw + SW_CG + (r - 3072); stride = 16; }
#pragma unroll
                        for (int b = 0; b < 4; ++b) dst[(size_t)b * stride] = sb[b]; }
                }
            }
        }
    { const float* x = (const float*)a->in[0]; const float* nw = (const float*)a->in[5]; bf16* XS = (bf16*)(F.ws + WS_XS); float* rss = (float*)(F.ws + WS_ROWSS);
        for (int row0 = gw; row0 < M; row0 += 2 * NGW) {
            f32x4 v[2][4];
#pragma unroll
            for (int q2 = 0; q2 < 2; ++q2)
#pragma unroll
                for (int j = 0; j < 4; ++j) v[q2][j] = *(const f32x4*)(x + (size_t)(row0 + q2 * NGW) * D + 4 * F.lane + 256 * j);
#pragma unroll
            for (int q2 = 0; q2 < 2; ++q2) { const int row = row0 + q2 * NGW, b = row >> 12; float ss = 0.f;
#pragma unroll
                for (int j = 0; j < 4; ++j) { const int c = 4 * F.lane + 256 * j; const f32x4 vv = v[q2][j];
                    const f32x4 g = *(const f32x4*)(nw + c), sc = *(const f32x4*)(MOD + (size_t)b * MODW + D + c);
                    ss += (vv[0] * vv[0] + vv[1] * vv[1]) + (vv[2] * vv[2] + vv[3] * vv[3]);
                    const f32x4 o = vv * g * (sc + 1.f);
                    *(unsigned long long*)(XS + (size_t)row * D + c) = (unsigned long long)pk2(o[0], o[1]) | ((unsigned long long)pk2(o[2], o[3]) << 32); }
                ss = wave_sum(ss); if (F.lane == 0) rss[row] = ss; }
        } }
}
}

namespace {
typedef short s16x8 __attribute__((ext_vector_type(8)));
typedef float f32x16 __attribute__((ext_vector_type(16)));
typedef unsigned u32x2v __attribute__((ext_vector_type(2)));
__device__ __forceinline__ int crow32(int r, int hi) { return (r & 3) + 8 * (r >> 2) + 4 * hi; }
__device__ __forceinline__ float logsig16(float z) { return (fminf(z, 0.f) - __logf(1.0f + __expf(-fabsf(z)))) * (1.0f / 16.0f); }

__device__ __forceinline__ void conv_unit(Frame& F, ArgsP a, int l, int unit) {
    const bf16* HG = (const bf16*)(F.ws + WS_HGLU); bf16* CC = (bf16*)(F.ws + WS_CONCAT);
    const int b = unit >> 6, t0 = (unit & 63) * 64;
    LAS bf16* tile = (LAS bf16*)F.lds;
    for (int p = F.tid; p < 94 * 32; p += NTHREADS) { const int r = p >> 5, ch = (p & 31) * 8; const int t = t0 - 30 + r;
        v4u v = {0u, 0u, 0u, 0u}; if (t >= 0) v = *(const v4u*)(HG + ((size_t)b * S + t) * 256 + ch);
        *(LAS v4u*)(tile + r * 256 + ch) = v; }
    LAS float* wl = (LAS float*)(F.lds + 49152);
    { const float* cwg = (const float*)a->in[12] + (size_t)l * 31 * 256; for (int p = F.tid; p < 31 * 64; p += NTHREADS) *(LAS f32x4*)(wl + 4 * p) = *(const f32x4*)(cwg + 4 * p); }
    __syncthreads();
    const int c = F.tid & 255, half = F.tid >> 8;
    float w[31];
#pragma unroll
    for (int j = 0; j < 31; ++j) w[j] = wl[j * 256 + c];
    const float bias = ((const float*)a->in[13])[l * 256 + c], ng = ((const float*)a->in[14])[l * 256 + c], nb = ((const float*)a->in[15])[l * 256 + c];
    bf16* dst = CC + ((size_t)b * S + t0 + 32 * half) * D + 512 + c;
#pragma unroll 1
    for (int g = 0; g < 8; ++g) {
        const LAS bf16* tp = tile + (32 * half + 4 * g) * 256 + c;
        float xw[34];
#pragma unroll
        for (int i = 0; i < 34; ++i) xw[i] = bf2f(tp[i * 256]);
#pragma unroll
        for (int j = 0; j < 4; ++j) { float acc = bias;
#pragma unroll
            for (int tap = 0; tap < 31; ++tap) acc += w[tap] * xw[j + tap];
            const float mu = wave_sum(acc) * (1.0f / 64.0f); const float xc = acc - mu;
            const float var = wave_sum(xc * xc) * (1.0f / 64.0f);
            const float y = xc * __builtin_amdgcn_rsqf(var + EPS) * ng + nb;
            dst[(size_t)(4 * g + j) * D] = (bf16)f2bf(y * __builtin_amdgcn_rcpf(1.f + __expf(-y))); }
    }
    __syncthreads();
}

__device__ __forceinline__ void gla_ls_image(Frame& F, ArgsP a, int l, const LAS float* cg, const LAS float* gwl, LAS float* ls) {
    const int r32 = F.lane & 31, hi = F.lane >> 5, cch = 32 * F.wave + r32;
    float bcol[8];
#pragma unroll
    for (int s = 0; s < 8; ++s) bcol[s] = gwl[(2 * s + hi) * 256 + cch];
    const float gbv = ((const float*)a->in[17])[l * 256 + cch];
    f32x16 z[2];
#pragma unroll
    for (int tt = 0; tt < 2; ++tt) {
        const LAS float* cr = cg + (32 * tt + r32) * 16;
        const f32x4 c0 = *(const LAS f32x4*)cr, c1 = *(const LAS f32x4*)(cr + 4), c2 = *(const LAS f32x4*)(cr + 8), c3 = *(const LAS f32x4*)(cr + 12);
        const float ar[16] = {c0[0], c0[1], c0[2], c0[3], c1[0], c1[1], c1[2], c1[3], c2[0], c2[1], c2[2], c2[3], c3[0], c3[1], c3[2], c3[3]};
        z[tt] = (f32x16){};
#pragma unroll
        for (int s = 0; s < 8; ++s) z[tt] = __builtin_amdgcn_mfma_f32_32x32x2f32(hi ? ar[2 * s + 1] : ar[2 * s], bcol[s], z[tt], 0, 0, 0);
    }
    __syncthreads();
#pragma unroll
    for (int tt = 0; tt < 2; ++tt)
#pragma unroll
        for (int r = 0; r < 16; ++r) ls[(32 * tt + crow32(r, hi)) * 256 + cch] = logsig16(z[tt][r] + gbv);
    __syncthreads();
}

constexpr int GP72 = 72;
__device__ __forceinline__ void gla_local_unit(Frame& F, ArgsP a, int l, int unit) {
    const int b = unit >> 6, n = unit & 63; const size_t row0 = (size_t)b * S + n * 64;
    LAS float* cg = (LAS float*)F.lds;
    LAS float* gwl = (LAS float*)(F.lds + 4096);
    LAS float* part = (LAS float*)(F.lds + 20480);
    LAS float* ls = (LAS float*)F.lds;
    LAS bf16* keT = (LAS bf16*)(F.lds + 65536);
    LAS bf16* vT = (LAS bf16*)(F.lds + 65536 + 36864);
    const bf16* XS = (const bf16*)(F.ws + WS_XS); const bf16* wcg = (const bf16*)(F.ws + WS_WCG) + (size_t)l * 16 * D;
    const int c = F.tid & 255, half = F.tid >> 8;
    unsigned short kreg[32], vreg[32];
    { const bf16* CK = (const bf16*)(F.ws + WS_CK) + (row0 + 32 * half) * 256 + c; const bf16* CV = (const bf16*)(F.ws + WS_CV) + (row0 + 32 * half) * 256 + c;
#pragma unroll
        for (int i = 0; i < 32; ++i) { kreg[i] = CK[(size_t)i * 256]; vreg[i] = CV[(size_t)i * 256]; } }
    f32x4 gwr[2];
    { const float* gwg = (const float*)a->in[16] + (size_t)l * 16 * 256;
#pragma unroll
        for (int i = 0; i < 2; ++i) gwr[i] = *(const f32x4*)(gwg + 4 * (F.tid + 512 * i)); }
    {
        const int fr = F.lane & 15, fq = F.lane >> 4;
        f32x4 acc[4];
#pragma unroll
        for (int rt = 0; rt < 4; ++rt) acc[rt] = (f32x4){0.f, 0.f, 0.f, 0.f};
#pragma unroll
        for (int ks = 0; ks < 4; ++ks) { const int k0 = F.wave * 128 + ks * 32 + 8 * fq;
            const s16x8 bfr = *(const s16x8*)(wcg + (size_t)fr * D + k0);
#pragma unroll
            for (int rt = 0; rt < 4; ++rt) { const s16x8 afr = *(const s16x8*)(XS + (row0 + 16 * rt + fr) * D + k0);
                acc[rt] = __builtin_amdgcn_mfma_f32_16x16x32_bf16(afr, bfr, acc[rt], 0, 0, 0); } }
#pragma unroll
        for (int rt = 0; rt < 4; ++rt)
#pragma unroll
            for (int j = 0; j < 4; ++j) part[(F.wave * 64 + 16 * rt + 4 * fq + j) * 16 + fr] = acc[rt][j];
    }
#pragma unroll
    for (int i = 0; i < 32; i += 2) *(LAS unsigned*)(vT + c * GP72 + 32 * half + i) = (unsigned)vreg[i] | ((unsigned)vreg[i + 1] << 16);
#pragma unroll
    for (int i = 0; i < 2; ++i) *(LAS f32x4*)(gwl + 4 * (F.tid + 512 * i)) = gwr[i];
    __syncthreads();
    {
        const float* rowss = (const float*)(F.ws + WS_ROWSS) + (size_t)(3 * l + 1) * M; const float* swcg = (const float*)(F.ws + WS_SW) + (size_t)l * SWL + SW_CG + b * 16;
        float* CG = (float*)(F.ws + WS_CG);
#pragma unroll
        for (int q = 0; q < 2; ++q) { const int o = F.tid + 512 * q, tok = o >> 4, nn = o & 15; float s = 0.f;
#pragma unroll
            for (int w8 = 0; w8 < 8; ++w8) s += part[(w8 * 64 + tok) * 16 + nn];
            const float r = rsqrtf(rowss[row0 + tok] * (1.0f / 1024.0f) + EPS);
            const float v = r * s + swcg[nn]; cg[o] = v; CG[(row0 + tok) * 16 + nn] = v; }
    }
    __syncthreads();
    gla_ls_image(F, a, l, cg, gwl, ls);
    {
        float off = 0.f, tot = 0.f;
#pragma unroll 8
        for (int t = 0; t < 32; ++t) off += ls[t * 256 + c];
#pragma unroll 8
        for (int t = 32; t < 64; ++t) tot += ls[t * 256 + c];
        const float Glast = off + tot;
        float G = half ? off : 0.f;
#pragma unroll
        for (int i = 0; i < 32; i += 2) {
            G += ls[(32 * half + i) * 256 + c]; const float k0 = bf2f(kreg[i]) * __expf(Glast - G);
            G += ls[(32 * half + i + 1) * 256 + c]; const float k1 = bf2f(kreg[i + 1]) * __expf(Glast - G);
            *(LAS unsigned*)(keT + c * GP72 + 32 * half + i) = pk2(k0, k1);
        }
        if (half == 1) ((float*)(F.ws + WS_DEC))[((size_t)(b * 4 + (c >> 6)) * 64 + n) * 64 + (c & 63)] = __expf(Glast);
    }
    __syncthreads();
    {
        const int h = F.wave >> 1, et = F.wave & 1, r32 = F.lane & 31, hi = F.lane >> 5;
        float* KVT = (float*)(F.ws + WS_KV) + ((size_t)(b * 4 + h) * 64 + n) * 4096;
#pragma unroll
        for (int dt = 0; dt < 2; ++dt) { f32x16 acc = {};
#pragma unroll
            for (int ks = 0; ks < 4; ++ks) { const s16x8 af = *(const LAS s16x8*)(vT + (h * 64 + 32 * et + r32) * GP72 + 16 * ks + 8 * hi);
                const s16x8 bf = *(const LAS s16x8*)(keT + (h * 64 + 32 * dt + r32) * GP72 + 16 * ks + 8 * hi);
                acc = __builtin_amdgcn_mfma_f32_32x32x16_bf16(af, bf, acc, 0, 0, 0); }
#pragma unroll
            for (int r = 0; r < 16; ++r) KVT[(size_t)(32 * et + crow32(r, hi)) * 64 + 32 * dt + r32] = acc[r]; }
    }
    __syncthreads();
}

__device__ __forceinline__ void gla_scan_unit(Frame& F, int unit) {
    const int bh = unit >> 3, idx = (unit & 7) * 512 + F.tid, d = idx & 63;
    const float* KVT = (const float*)(F.ws + WS_KV) + (size_t)bh * 64 * 4096 + idx; const float* DEC = (const float*)(F.ws + WS_DEC) + (size_t)bh * 64 * 64 + d;
    bf16* SPT = (bf16*)(F.ws + WS_SPT) + (size_t)bh * 64 * 4096 + idx;
    float s = 0.f;
    for (int n0 = 0; n0 < 64; n0 += 8) { float kv[8], dc[8];
#pragma unroll
        for (int j = 0; j < 8; ++j) { kv[j] = KVT[(size_t)(n0 + j) * 4096]; dc[j] = DEC[(n0 + j) * 64]; }
#pragma unroll
        for (int j = 0; j < 8; ++j) { SPT[(size_t)(n0 + j) * 4096] = (bf16)f2bf(s); s = dc[j] * s + kv[j]; } }
}

__device__ __forceinline__ void gla_out_unit(Frame& F, ArgsP a, int l, int unit) {
    const int b = unit >> 6, n = unit & 63; const size_t row0 = (size_t)b * S + n * 64;
    LAS float* cg = (LAS float*)F.lds;
    LAS float* gwl = (LAS float*)(F.lds + 4096);
    LAS float* ls = (LAS float*)F.lds;
    LAS bf16* vT = (LAS bf16*)F.lds;
    LAS bf16* qt = (LAS bf16*)(F.lds + 65536);
    LAS bf16* kt = (LAS bf16*)(F.lds + 65536 + 36864);
    const int c = F.tid & 255, half = F.tid >> 8, hh = c >> 6, dd = c & 63;
    v4u qreg[4], kreg[4];
#pragma unroll
    for (int i = 0; i < 4; ++i) { const int p = F.tid + 512 * i; qreg[i] = *(const v4u*)((const bf16*)(F.ws + WS_CQ) + (row0 + (p >> 5)) * 256 + (p & 31) * 8);
        kreg[i] = *(const v4u*)((const bf16*)(F.ws + WS_CK) + (row0 + (p >> 5)) * 256 + (p & 31) * 8); }
    unsigned short vreg[32];
    { const bf16* CV = (const bf16*)(F.ws + WS_CV) + (row0 + 32 * half) * 256 + c;
#pragma unroll
        for (int i = 0; i < 32; ++i) vreg[i] = CV[(size_t)i * 256]; }
    f32x4 gwr[2]; float cgr[2];
    { const float* gwg = (const float*)a->in[16] + (size_t)l * 16 * 256; const float* CG = (const float*)(F.ws + WS_CG) + row0 * 16;
#pragma unroll
        for (int i = 0; i < 2; ++i) { gwr[i] = *(const f32x4*)(gwg + 4 * (F.tid + 512 * i)); cgr[i] = CG[F.tid + 512 * i]; } }
#pragma unroll
    for (int i = 0; i < 2; ++i) { *(LAS f32x4*)(gwl + 4 * (F.tid + 512 * i)) = gwr[i]; cg[F.tid + 512 * i] = cgr[i]; }
#pragma unroll
    for (int i = 0; i < 4; ++i) { const int p = F.tid + 512 * i, t = p >> 5, ch = (p & 31) * 8; const int o = ((ch >> 6) * 64 + t) * GP72 + (ch & 63);
        *(LAS v4u*)(qt + o) = qreg[i]; *(LAS v4u*)(kt + o) = kreg[i]; }
    __syncthreads();
    gla_ls_image(F, a, l, cg, gwl, ls);
    {
        float G = 0.f;
        if (half) {
#pragma unroll 8
            for (int t = 0; t < 32; ++t) G += ls[t * 256 + c]; }
#pragma unroll 4
        for (int i = 0; i < 32; ++i) { const int o = (hh * 64 + 32 * half + i) * GP72 + dd;
            G += ls[(32 * half + i) * 256 + c]; const float e0 = __expf(G);
            qt[o] = (bf16)f2bf(bf2f(qt[o]) * 0.125f * e0);
            kt[o] = (bf16)f2bf(bf2f(kt[o]) * __builtin_amdgcn_rcpf(e0)); }
    }
    __syncthreads();
#pragma unroll
    for (int i = 0; i < 32; i += 2) *(LAS unsigned*)(vT + c * GP72 + 32 * half + i) = (unsigned)vreg[i] | ((unsigned)vreg[i + 1] << 16);
    __syncthreads();
    const int h = F.wave >> 1, sub = F.wave & 1, r32 = F.lane & 31, hi = F.lane >> 5;
    f32x16 am[2];
#pragma unroll
    for (int mt = 0; mt < 2; ++mt) { am[mt] = (f32x16){};
#pragma unroll
        for (int ks = 0; ks < 4; ++ks) { const s16x8 af = *(const LAS s16x8*)(kt + (h * 64 + 32 * mt + r32) * GP72 + 16 * ks + 8 * hi);
            const s16x8 bf = *(const LAS s16x8*)(qt + (h * 64 + 32 * sub + r32) * GP72 + 16 * ks + 8 * hi);
            am[mt] = __builtin_amdgcn_mfma_f32_32x32x16_bf16(af, bf, am[mt], 0, 0, 0); } }
    __syncthreads();
    { const int lq = 32 * sub + r32;
#pragma unroll
        for (int mt = 0; mt < 2; ++mt)
#pragma unroll
            for (int g4 = 0; g4 < 4; ++g4) { float v[4];
#pragma unroll
                for (int j = 0; j < 4; ++j) { const int mm = 32 * mt + 8 * g4 + 4 * hi + j; v[j] = (mm <= lq) ? am[mt][4 * g4 + j] : 0.f; }
                u32x2v w; w.x = pk2(v[0], v[1]); w.y = pk2(v[2], v[3]);
                *(LAS u32x2v*)(kt + (h * 64 + lq) * GP72 + 32 * mt + 8 * g4 + 4 * hi) = w; } }
    __syncthreads();
    const bf16* SPT = (const bf16*)(F.ws + WS_SPT) + ((size_t)(b * 4 + h) * 64 + n) * 4096;
    f32x16 o[2];
#pragma unroll
    for (int et = 0; et < 2; ++et) { o[et] = (f32x16){};
#pragma unroll
        for (int ks = 0; ks < 4; ++ks) { const s16x8 af = *(const LAS s16x8*)(vT + (h * 64 + 32 * et + r32) * GP72 + 16 * ks + 8 * hi);
            const s16x8 bf = *(const LAS s16x8*)(kt + (h * 64 + 32 * sub + r32) * GP72 + 16 * ks + 8 * hi);
            o[et] = __builtin_amdgcn_mfma_f32_32x32x16_bf16(af, bf, o[et], 0, 0, 0); }
#pragma unroll
        for (int ks = 0; ks < 4; ++ks) { const s16x8 af = *(const s16x8*)(SPT + (size_t)(32 * et + r32) * 64 + 16 * ks + 8 * hi);
            const s16x8 bf = *(const LAS s16x8*)(qt + (h * 64 + 32 * sub + r32) * GP72 + 16 * ks + 8 * hi);
            o[et] = __builtin_amdgcn_mfma_f32_32x32x16_bf16(af, bf, o[et], 0, 0, 0); } }
    float ss = 0.f;
#pragma unroll
    for (int et = 0; et < 2; ++et)
#pragma unroll
        for (int r = 0; r < 16; ++r) ss += o[et][r] * o[et][r];
    ss = add_x32(ss);
    const float rn = rsqrtf(ss * (1.0f / 64.0f) + EPS);
    const size_t row = row0 + 32 * sub + r32;
    const bf16* CR = (const bf16*)(F.ws + WS_CR) + row * 256 + h * 64; bf16* CC = (bf16*)(F.ws + WS_CONCAT) + row * D + 768 + h * 64;
    const float* gn = (const float*)a->in[18] + l * 64;
#pragma unroll
    for (int et = 0; et < 2; ++et)
#pragma unroll
        for (int g4 = 0; g4 < 4; ++g4) { const int e0 = 32 * et + 8 * g4 + 4 * hi;
            const u32x2v cr = *(const u32x2v*)(CR + e0); const f32x4 gv = *(const f32x4*)(gn + e0);
            float y[4];
#pragma unroll
            for (int j = 0; j < 4; ++j) { const float crv = __builtin_bit_cast(float, (j & 1) ? ((j < 2 ? cr.x : cr.y) & 0xffff0000u) : ((j < 2 ? cr.x : cr.y) << 16));
                y[j] = o[et][4 * g4 + j] * rn * gv[j] * (crv / (1.f + __expf(-crv))); }
            u32x2v w; w.x = pk2(y[0], y[1]); w.y = pk2(y[2], y[3]);
            *(u32x2v*)(CC + e0) = w; }
    __syncthreads();
}
}
#include <hip/hip_bf16.h>
#include <cmath>
namespace attn_body {
using bf16=__hip_bfloat16;
using bf16x8=__attribute__((ext_vector_type(8)))short;
using s16x4=__attribute__((ext_vector_type(4)))short;
using f32x16=__attribute__((ext_vector_type(16)))float;
using u32x4=__attribute__((ext_vector_type(4)))unsigned;
constexpr int BATCH=4,NHEAD=8,SEQ=4096,D=64,DM=NHEAD*D,DMO=1024;
constexpr int NW=8,QBLK=32,QB=QBLK*NW,KVBLK=64,NQB=SEQ/QB;
constexpr int ATTN_PITCH=DM, ATTN_UNIT_ROWS=QB;
__device__ __forceinline__ int crow(int r,int hi){return (r&3)+8*(r>>2)+4*hi;}
#define SBAR() __builtin_amdgcn_sched_barrier(0)
__device__ __forceinline__ void cmask(f32x16&p0,f32x16&p1,int jb,int qrel,int hi){
  const float NEG=-INFINITY; int kb=64*jb+4*hi;
  #pragma unroll
  for(int r=0;r<16;++r){int kv=kb+(r&3)+8*(r>>2); if(kv>qrel)p0[r]=NEG; if(kv+32>qrel)p1[r]=NEG;}
}

__device__ __forceinline__ void smask(f32x16&p0,f32x16&p1,unsigned keep){
  const float NEG=-INFINITY;
  #pragma unroll
  for(int r=0;r<16;++r){ if(!keep){p0[r]=NEG;p1[r]=NEG;} }
}
constexpr int NSLOT=3, SLOTB=8192;
constexpr int LDS_K=0, LDS_V=NSLOT*SLOTB, LDS_WS=2*NSLOT*SLOTB, LDS_OST=LDS_WS+NW*64*4, LDS_BYTES=LDS_OST+NW*4096;
constexpr float C2=0.125f*1.4426950408889634f;
__device__ __forceinline__ void glds16(const void*gsrc,unsigned lds_dst){unsigned keep;
  asm volatile("s_mov_b32 %0, m0\n\ts_mov_b32 m0, %2\n\ts_nop 0\n\tglobal_load_lds_dwordx4 %1, off\n\ts_mov_b32 m0, %0":"=&s"(keep):"v"(gsrc),"s"(lds_dst):"memory");}
__device__ __forceinline__ float max3f(float a,float b,float c){float r;asm("v_max3_f32 %0, %1, %2, %3":"=v"(r):"v"(a),"v"(b),"v"(c));return r;}
__device__ __forceinline__ float max2f(float a,float b){float r;asm("v_max_f32_e32 %0, %1, %2":"=v"(r):"v"(a),"v"(b));return r;}
__device__ __forceinline__ float fadd_s(float a,float b){float r;asm("v_add_f32_e32 %0, %1, %2":"=v"(r):"v"(a),"v"(b));return r;}
__device__ __forceinline__ float fsub_s(float a,float b){float r;asm("v_sub_f32_e32 %0, %1, %2":"=v"(r):"v"(a),"v"(b));return r;}
typedef float f32x2_t __attribute__((ext_vector_type(2))); typedef __bf16 bf16x2_t __attribute__((ext_vector_type(2)));
__device__ __forceinline__ unsigned cvtpk_s(float lo,float hi){f32x2_t v={lo,hi};bf16x2_t b=__builtin_convertvector(v,bf16x2_t);return __builtin_bit_cast(unsigned,b);}
#define WAIT_BAR(N) asm volatile("s_waitcnt vmcnt(" #N ") lgkmcnt(0)\n\ts_barrier":::"memory")

__device__ __forceinline__ void qkt(f32x16&p0,f32x16&p1,const char*Kslot,const bf16x8*qr,const f32x16&negm,int r32,int hi){
  const char*kb=Kslot+hi*1024+r32*16;
  #pragma unroll
  for(int d0=0;d0<4;++d0){
    const bf16x8 b0=*reinterpret_cast<const bf16x8*>(kb+d0*2048);
    const bf16x8 b1=*reinterpret_cast<const bf16x8*>(kb+d0*2048+512);
    if(d0==0){p0=__builtin_amdgcn_mfma_f32_32x32x16_bf16(b0,qr[0],negm,0,0,0);p1=__builtin_amdgcn_mfma_f32_32x32x16_bf16(b1,qr[0],negm,0,0,0);}
    else{p0=__builtin_amdgcn_mfma_f32_32x32x16_bf16(b0,qr[d0],p0,0,0,0);p1=__builtin_amdgcn_mfma_f32_32x32x16_bf16(b1,qr[d0],p1,0,0,0);}}
}
typedef __attribute__((address_space(3))) const char* lds_cptr;
typedef short v4i16_t __attribute__((ext_vector_type(4)));
__device__ __forceinline__ void kload8(bf16x8*kf,lds_cptr kp){
  kf[0]=*(const __attribute__((address_space(3))) bf16x8*)(kp);      kf[1]=*(const __attribute__((address_space(3))) bf16x8*)(kp+512);
  kf[2]=*(const __attribute__((address_space(3))) bf16x8*)(kp+2048); kf[3]=*(const __attribute__((address_space(3))) bf16x8*)(kp+2560);
  kf[4]=*(const __attribute__((address_space(3))) bf16x8*)(kp+4096); kf[5]=*(const __attribute__((address_space(3))) bf16x8*)(kp+4608);
  kf[6]=*(const __attribute__((address_space(3))) bf16x8*)(kp+6144); kf[7]=*(const __attribute__((address_space(3))) bf16x8*)(kp+6656);
}
__device__ __forceinline__ void kload2(bf16x8*kf,lds_cptr kp,int j){ kf[2*j]=*(const __attribute__((address_space(3))) bf16x8*)(kp+j*2048); kf[2*j+1]=*(const __attribute__((address_space(3))) bf16x8*)(kp+j*2048+512); }
__device__ __forceinline__ s16x4 vtr(lds_cptr p){ return __builtin_bit_cast(s16x4,__builtin_amdgcn_ds_read_tr16_b64_v4i16((__attribute__((address_space(3))) v4i16_t*)p)); }
__device__ __forceinline__ float rowmax(const f32x16&p0,const f32x16&p1){
  float a=max3f(p0[0],p0[1],p1[0]),b=max3f(p0[2],p0[3],p1[1]);a=max3f(a,p1[2],p1[3]);
  #pragma unroll
  for(int r=4;r<16;r+=4){a=max3f(a,p0[r],p0[r+1]);b=max3f(b,p0[r+2],p0[r+3]);a=max3f(a,p1[r],p1[r+1]);b=max3f(b,p1[r+2],p1[r+3]);}
  const float m=max2f(a,b);
  auto rr=__builtin_amdgcn_permlane32_swap(__float_as_uint(m),__float_as_uint(m),false,false);
  return max2f(__uint_as_float(rr[0]),__uint_as_float(rr[1]));
}
__device__ __forceinline__ void pv(f32x16*o,int vb,bf16x8 pa0,bf16x8 pa1,bf16x8 pa2,bf16x8 pa3){
  #pragma unroll
  for(int d0=0;d0<2;++d0){s16x4 lo[4],hi[4];
    #pragma unroll
    for(int ks=0;ks<4;++ks){
      asm volatile("ds_read_b64_tr_b16 %0,%1 offset:%c2":"=&v"(lo[ks]):"v"(vb),"i"(d0*4096+ks*1024):"memory");
      asm volatile("ds_read_b64_tr_b16 %0,%1 offset:%c2":"=&v"(hi[ks]):"v"(vb),"i"(d0*4096+ks*1024+512):"memory");}
    asm volatile("s_waitcnt lgkmcnt(0)":::"memory");SBAR();
    #define PK(k) (bf16x8){lo[k][0],lo[k][1],lo[k][2],lo[k][3],hi[k][0],hi[k][1],hi[k][2],hi[k][3]}
    o[d0]=__builtin_amdgcn_mfma_f32_32x32x16_bf16(pa0,PK(0),o[d0],0,0,0);
    o[d0]=__builtin_amdgcn_mfma_f32_32x32x16_bf16(pa1,PK(1),o[d0],0,0,0);
    o[d0]=__builtin_amdgcn_mfma_f32_32x32x16_bf16(pa2,PK(2),o[d0],0,0,0);
    o[d0]=__builtin_amdgcn_mfma_f32_32x32x16_bf16(pa3,PK(3),o[d0],0,0,0);
    #undef PK
  }
}

#ifndef ATTN_STORE16
#define ATTN_STORE16(p,v) (*(u32x4*)(p)=(v))
#endif
template<int THRL> __device__ __forceinline__ void attn_unit(int b,int h,int qb,const bf16*Q,const bf16*__restrict__ K,const bf16*__restrict__ V,bf16*O,const float*__restrict__ KM,char*shm,int tid){
  const int lane=tid&63,r32=lane&31,hi=lane>>5; const int wid=__builtin_amdgcn_readfirstlane(tid>>6);
  const long rowbase=(long)b*SEQ; const int q0=qb*QB;
  const bf16*Qw=Q+(rowbase+q0+wid*QBLK)*DM+h*D;
  const bf16*Kh=K+rowbase*DM+h*D,*Vh=V+rowbase*DM+h*D;
  const unsigned lds0=(unsigned)(uintptr_t)shm;
  float*wsf=(float*)(shm+LDS_WS)+wid*64;
  const bf16*ksrc=Kh+(long)lane*DM+wid*8;
  const bf16*vsrc=Vh+(long)(16*(wid&3)+(lane>>2))*DM+(wid>>2)*32+(lane&3)*8;
  const unsigned kdst=lds0+LDS_K+wid*1024, vdst=lds0+LDS_V+wid*1024;
  #define AT(t) (((t)<4)?(NT-4+(t)):((t)-4))
  #define DMA_K(t,slot) glds16(ksrc+(long)AT(t)*KVBLK*DM,(unsigned)__builtin_amdgcn_readfirstlane(kdst+(slot)))
  #define DMA_V(t,slot) glds16(vsrc+(long)AT(t)*KVBLK*DM,(unsigned)__builtin_amdgcn_readfirstlane(vdst+(slot)))
  const int vb0=(int)(lds0+LDS_V)+((lane>>4)&1)*32+(lane&3)*8+(4*hi+((lane&15)>>2))*64;
  const char*Kbase=shm+LDS_K; bf16x8 kf[8];
  const lds_cptr shm3=(lds_cptr)shm; const lds_cptr kp0=shm3+LDS_K+hi*1024+r32*16; const lds_cptr vp0=shm3+LDS_V+((lane>>4)&1)*32+(lane&3)*8+(4*hi+((lane&15)>>2))*64;
  const int NT=(q0+QB)/KVBLK;
  DMA_K(0,0);DMA_V(0,0);DMA_K(1,SLOTB);
  bf16x8 qr[4];
  #pragma unroll
  for(int d0=0;d0<4;++d0)qr[d0]=*reinterpret_cast<const bf16x8*>(&Qw[(long)r32*DM+d0*16+hi*8]);
  unsigned selmask=0u;
  { float b0=-INFINITY,b1=-INFINITY,b2=-INFINITY; int i0=-1,i1=-1,i2=-1;
    float qf[32];
    #pragma unroll
    for(int d0=0;d0<4;++d0){
      #pragma unroll
      for(int j=0;j<8;++j)qf[8*d0+j]=__builtin_bit_cast(float,((unsigned)(unsigned short)qr[d0][j])<<16);}
    float*kml=reinterpret_cast<float*>(shm+LDS_OST+wid*4096);
    { const float4*kmg=reinterpret_cast<const float4*>(KM+(long)(b*NHEAD+h)*16*64);
      const float4 t0=kmg[lane],t1=kmg[lane+64],t2=kmg[lane+128],t3=kmg[lane+192];
      float4*kl4=reinterpret_cast<float4*>(kml); kl4[lane]=t0; kl4[lane+64]=t1; kl4[lane+128]=t2; kl4[lane+192]=t3;
      asm volatile("s_waitcnt lgkmcnt(0)":::"memory"); }
    for(int n=0;n<qb;++n){
      const float*km=kml+n*64+8*hi; float s=0.f;
      #pragma unroll
      for(int d0=0;d0<4;++d0){ const float4 ka=*reinterpret_cast<const float4*>(km+16*d0),kb=*reinterpret_cast<const float4*>(km+16*d0+4);
        s+=qf[8*d0]*ka.x+qf[8*d0+1]*ka.y+qf[8*d0+2]*ka.z+qf[8*d0+3]*ka.w+qf[8*d0+4]*kb.x+qf[8*d0+5]*kb.y+qf[8*d0+6]*kb.z+qf[8*d0+7]*kb.w; }
      s=add_x32(s);
      const bool g0=s>b0,g1=s>b1,g2=s>b2;
      b2=g1?b1:(g2?s:b2); i2=g1?i1:(g2?n:i2);
      b1=g0?b0:(g1?s:b1); i1=g0?i0:(g1?n:i1);
      b0=g0?s:b0;         i0=g0?n:i0; }
    if(i0>=0)selmask|=1u<<i0; if(i1>=0)selmask|=1u<<i1; if(i2>=0)selmask|=1u<<i2; }
  float mhat=0.f,l_reg=0.f;f32x16 o[2];o[0]=f32x16{};o[1]=f32x16{};f32x16 negm=f32x16{};asm volatile("":"+v"(negm));
  const int qrel=wid*QBLK+r32;
  #define CMASK(P0,P1,t) do{ if((t)<4)cmask(P0,P1,(t),qrel,hi); else smask(P0,P1,(selmask>>(((t)-4)>>2))&1u); }while(0)
  bool resc=false;
  #define START(P0,P1) do{ const float rm=rowmax(P0,P1); resc=false; \
    { const float dl=rm; mhat=fadd_s(mhat,dl); \
      _Pragma("unroll") for(int r=0;r<16;++r){P0[r]=fsub_s(P0[r],dl);P1[r]=fsub_s(P1[r],dl);} \
      _Pragma("unroll") for(int r=0;r<16;++r)negm[r]=-mhat; asm volatile("":"+v"(negm)); } \
    _Pragma("unroll") for(int r=0;r<16;++r)P0[r]=__builtin_amdgcn_exp2f(P0[r]); }while(0)
  #define RESC() do{ if(resc){ asm volatile("s_waitcnt lgkmcnt(0)":::"memory"); \
      _Pragma("unroll") for(int d_=0;d_<2;++d_) _Pragma("unroll") for(int r=0;r<16;++r)o[d_][r]*=wsf[crow(r,hi)]; } }while(0)
  f32x16 pA0,pA1,pB0,pB1;
  int sl_prev=0,sl_cur=0,sl_next=SLOTB;
  #define ROT() do{sl_prev=sl_cur;sl_cur=sl_next;sl_next=(sl_next==(NSLOT-1)*SLOTB)?0:sl_next+SLOTB;}while(0)
  DMA_K(2,2*SLOTB);
  WAIT_BAR(3);
  qkt(pA0,pA1,Kbase,qr,negm,r32,hi);asm volatile("s_nop 15\n\ts_nop 7":"+v"(pA0),"+v"(pA1));CMASK(pA0,pA1,0);
  START(pA0,pA1);
  _Pragma("unroll") for(int r=0;r<16;++r)pA1[r]=__builtin_amdgcn_exp2f(pA1[r]);
  WAIT_BAR(0);
  DMA_K(3,0);DMA_V(1,SLOTB);
  ROT();
  kload8(kf,kp0+sl_cur);
  WAIT_BAR(2);
  s16x4 vlo[8],vhi[8]; u32x4 pw0,pw1,pw2,pw3;
  #define PKW(P,B) cvtpk_s(P[B],P[B+1])
  #define PAF(k) __builtin_bit_cast(bf16x8,pw##k)
  #define VFR(i) (bf16x8){vlo[i][0],vlo[i][1],vlo[i][2],vlo[i][3],vhi[i][0],vhi[i][1],vhi[i][2],vhi[i][3]}
  #define PIN(x) asm volatile("":"+v"(x))
  #define MX3(a,b,c) __builtin_fmaxf(__builtin_fmaxf((a),(b)),(c))
  #define GAPA(MF,A0,A1,A2,A3,W0,W1,PW) do{ MF; sacc+=A0; sacc+=A1; sacc+=A2; sacc+=A3; PIN(sacc); W0; W1; PIN(PW); SBAR(); }while(0)
  #define EX(v) __builtin_amdgcn_exp2f(v)
  #define GAPB(MF,X,B) do{ MF; X[B]=EX(X[B]); X[B+1]=EX(X[B+1]); X[B+2]=EX(X[B+2]); X[B+3]=EX(X[B+3]); PIN(X); SBAR(); }while(0)
  #define VRD(i) do{ vlo[i]=vtr(vp_+(((i)>>2)*4096+((i)&3)*1024)); vhi[i]=vtr(vp_+(((i)>>2)*4096+((i)&3)*1024+512)); }while(0)
  #define KRD(G,j) do{ if(G){ kload2(kf,kp0+sl_next,j); SBAR(); } }while(0)
  #define STEP(C0,C1,P0,P1,t,GK,GV,GL) do{ SBAR(); \
    const lds_cptr vp_=vp0+sl_prev; \
    VRD(0); SBAR(); float sacc=(P0[0]+P0[1]); \
    GAPA(C0=__builtin_amdgcn_mfma_f32_32x32x16_bf16(kf[0],qr[0],negm,0,0,0), P0[2],P0[3],P0[4],P0[5],     pw0[0]=PKW(P0,0), pw0[1]=PKW(P0,2), pw0); \
    VRD(4); SBAR(); GAPA(C1=__builtin_amdgcn_mfma_f32_32x32x16_bf16(kf[1],qr[0],negm,0,0,0), P0[6],P0[7],P0[8],P0[9],     pw0[2]=PKW(P0,4), pw0[3]=PKW(P0,6), pw0); \
    VRD(1); SBAR(); GAPA(C0=__builtin_amdgcn_mfma_f32_32x32x16_bf16(kf[2],qr[1],C0,0,0,0),   P0[10],P0[11],P0[12],P0[13], pw1[0]=PKW(P0,8), pw1[1]=PKW(P0,10), pw1); \
    VRD(5); SBAR(); GAPA(C1=__builtin_amdgcn_mfma_f32_32x32x16_bf16(kf[3],qr[1],C1,0,0,0),   P0[14],P0[15],P1[0],P1[1],   pw1[2]=PKW(P0,12),pw1[3]=PKW(P0,14), pw1); \
    VRD(2); SBAR(); GAPA(C0=__builtin_amdgcn_mfma_f32_32x32x16_bf16(kf[4],qr[2],C0,0,0,0),   P1[2],P1[3],P1[4],P1[5],     pw2[0]=PKW(P1,0), pw2[1]=PKW(P1,2), pw2); \
    VRD(6); SBAR(); GAPA(C1=__builtin_amdgcn_mfma_f32_32x32x16_bf16(kf[5],qr[2],C1,0,0,0),   P1[6],P1[7],P1[8],P1[9],     pw2[2]=PKW(P1,4), pw2[3]=PKW(P1,6), pw2); \
    VRD(3); SBAR(); GAPA(C0=__builtin_amdgcn_mfma_f32_32x32x16_bf16(kf[6],qr[3],C0,0,0,0),   P1[10],P1[11],P1[12],P1[13], pw3[0]=PKW(P1,8), pw3[1]=PKW(P1,10), pw3); \
    VRD(7); SBAR(); GAPA(C1=__builtin_amdgcn_mfma_f32_32x32x16_bf16(kf[7],qr[3],C1,0,0,0),   P1[14],P1[15],0.f,0.f,       pw3[2]=PKW(P1,12),pw3[3]=PKW(P1,14), pw3); \
    l_reg+=sacc; \
    if(GK){DMA_K((t)+3,sl_cur);} if(GV){DMA_V((t)+1,sl_next);} \
    CMASK(C0,C1,t); \
    { float a=MX3(C0[0],C0[1],C1[0]),b=MX3(C0[2],C0[3],C1[1]); a=MX3(a,C1[2],C1[3]); \
      _Pragma("unroll") for(int r=4;r<16;r+=4){a=MX3(a,C0[r],C0[r+1]);b=MX3(b,C0[r+2],C0[r+3]);a=MX3(a,C1[r],C1[r+1]);b=MX3(b,C1[r+2],C1[r+3]);} \
      float rm=__builtin_fmaxf(a,b); { auto rr=__builtin_amdgcn_permlane32_swap(__float_as_uint(rm),__float_as_uint(rm),false,false); rm=__builtin_fmaxf(__uint_as_float(rr[0]),__uint_as_float(rr[1])); } \
      resc=false; \
      if(__builtin_expect(__any(rm>(float)THRL),0)){ const float dl=__builtin_fmaxf(rm,0.f); mhat+=dl; \
        _Pragma("unroll") for(int r=0;r<16;++r){C0[r]-=dl;C1[r]-=dl;} \
        _Pragma("unroll") for(int r=0;r<16;++r)negm[r]=-mhat; asm volatile("":"+v"(negm)); \
        const float f=__builtin_amdgcn_exp2f(-dl); l_reg*=f; if(hi==0)wsf[r32]=f; resc=true; } } \
    SBAR(); \
    GAPB(o[0]=__builtin_amdgcn_mfma_f32_32x32x16_bf16(PAF(0),VFR(0),o[0],0,0,0), C0,0); \
    GAPB(o[1]=__builtin_amdgcn_mfma_f32_32x32x16_bf16(PAF(0),VFR(4),o[1],0,0,0), C0,4); \
    KRD(GL,0); GAPB(o[0]=__builtin_amdgcn_mfma_f32_32x32x16_bf16(PAF(1),VFR(1),o[0],0,0,0), C0,8); \
    KRD(GL,1); GAPB(o[1]=__builtin_amdgcn_mfma_f32_32x32x16_bf16(PAF(1),VFR(5),o[1],0,0,0), C0,12); \
    KRD(GL,2); GAPB(o[0]=__builtin_amdgcn_mfma_f32_32x32x16_bf16(PAF(2),VFR(2),o[0],0,0,0), C1,0); \
    KRD(GL,3); GAPB(o[1]=__builtin_amdgcn_mfma_f32_32x32x16_bf16(PAF(2),VFR(6),o[1],0,0,0), C1,4); \
    GAPB(o[0]=__builtin_amdgcn_mfma_f32_32x32x16_bf16(PAF(3),VFR(3),o[0],0,0,0), C1,8); \
    GAPB(o[1]=__builtin_amdgcn_mfma_f32_32x32x16_bf16(PAF(3),VFR(7),o[1],0,0,0), C1,12); \
    }while(0)
  int t=1;
  for(;t+5<NT;t+=2){
    STEP(pB0,pB1,pA0,pA1,t,true,true,true);     WAIT_BAR(2); RESC(); ROT();
    STEP(pA0,pA1,pB0,pB1,t+1,true,true,true);   WAIT_BAR(2); RESC(); ROT();
  }
  #define ENDW(tt) do{ if((tt)+3<NT){WAIT_BAR(2);} else if((tt)+2<NT){WAIT_BAR(1);} else {WAIT_BAR(0);} }while(0)
  for(;t+1<NT;t+=2){
    STEP(pB0,pB1,pA0,pA1,t,(t+3<NT),(t+1<NT),(t+1<NT));       ENDW(t);   RESC(); ROT();
    STEP(pA0,pA1,pB0,pB1,t+1,(t+4<NT),(t+2<NT),(t+2<NT));     ENDW(t+1); RESC(); ROT();
  }
  STEP(pB0,pB1,pA0,pA1,NT-1,false,false,false); RESC();
  { float sacc=pB0[0]+pB0[1]; _Pragma("unroll") for(int r=2;r<16;++r)sacc+=pB0[r]; _Pragma("unroll") for(int r=0;r<16;++r)sacc+=pB1[r]; l_reg+=sacc;
    pw0=(u32x4){PKW(pB0,0),PKW(pB0,2),PKW(pB0,4),PKW(pB0,6)};pw1=(u32x4){PKW(pB0,8),PKW(pB0,10),PKW(pB0,12),PKW(pB0,14)};pw2=(u32x4){PKW(pB1,0),PKW(pB1,2),PKW(pB1,4),PKW(pB1,6)};pw3=(u32x4){PKW(pB1,8),PKW(pB1,10),PKW(pB1,12),PKW(pB1,14)};
    SBAR(); pv(o,vb0+sl_cur,PAF(0),PAF(1),PAF(2),PAF(3)); }
  #undef PKW
  #undef PAF
  #undef VFR
  #undef PIN
  #undef MX3
  #undef GAPA
  #undef GAPB
  #undef EX
  #undef VRD
  #undef KRD
  #undef STEP
  #undef ENDW
  {auto rr=__builtin_amdgcn_permlane32_swap(__float_as_uint(l_reg),__float_as_uint(l_reg),false,false);l_reg=__uint_as_float(rr[0])+__uint_as_float(rr[1]);}
  if(hi==0)wsf[32+r32]=l_reg;asm volatile("s_waitcnt lgkmcnt(0)":::"memory");
  float rli[16];
  #pragma unroll
  for(int r=0;r<16;++r)rli[r]=__builtin_amdgcn_rcpf(wsf[32+crow(r,hi)]);
  bf16*Ow=O+(rowbase+q0+wid*QBLK)*DMO+h*D;
  { bf16*stg=(bf16*)(shm+LDS_OST)+wid*2048;
    #pragma unroll
    for(int r=0;r<16;++r){const int orow=crow(r,hi);
      #pragma unroll
      for(int d0=0;d0<2;++d0)stg[orow*64+d0*32+r32]=__float2bfloat16(o[d0][r]*rli[r]);}
    asm volatile("s_waitcnt lgkmcnt(0)":::"memory");
    #pragma unroll
    for(int i=0;i<4;++i){const int row=i*8+(lane>>3),ch=lane&7; const u32x4 v=*(const u32x4*)(stg+row*64+ch*8); ATTN_STORE16(Ow+(long)row*DMO+ch*8,v);} }
  asm volatile("s_waitcnt lgkmcnt(0)\n\ts_barrier":::"memory");
  #undef DMA_K
  #undef AT
  #undef DMA_V
  #undef CMASK
  #undef START
  #undef RESC
  #undef ROT
}
constexpr int ATTN_LDS_BYTES=LDS_BYTES;
struct AttnTensors { const bf16* Q; const bf16* K; const bf16* V; bf16* O; const float* KM; };
struct AttnUnit { int bh; int qb; };
struct StaticOrder {
  int vcu;
  __device__ __forceinline__ explicit StaticOrder(int grid,int block):vcu((block%8)*(grid/8)+block/8){}
  __device__ __forceinline__ bool next(int i,AttnUnit&u)const{ if(i>=2)return false; const int s=vcu&7; u.bh=vcu>>3; u.qb=(i==0)?15-s:s; return true; }
  __device__ __forceinline__ void a_ready(const AttnUnit&)const{}
  __device__ __forceinline__ void done(const AttnUnit&)const{}
};
template<class Sched,int THRL=8> __device__ __forceinline__ void attn_phase(char*lds,const AttnTensors&T,const Sched&S,int tid_wave){
  AttnUnit u;
  for(int i=0;S.next(i,u);++i){ int l_; asm volatile("v_mbcnt_lo_u32_b32 %0, -1, 0\n\tv_mbcnt_hi_u32_b32 %0, -1, %0":"=v"(l_)); const int t_=tid_wave*64+l_;
    S.a_ready(u); attn_unit<THRL>(u.bh/NHEAD,u.bh%NHEAD,u.qb,T.Q,T.K,T.V,T.O,T.KM,lds,t_); S.done(u); }
}
#undef SBAR
#undef WAIT_BAR
}
namespace {
#define XB_TMO      128
#define XB_XCNT(j)  (256  + 64 * (j))
#define XB_XSUB(j)  (1280 + 64 * (j))
#define XB_XGEN(j)  (2304 + 64 * (j))
#define XB_TOP      3328
#define XB_TOPGEN   3392
#define XCD_BAR_WORDS 3456
#define XB_SPIN_CAP (1u << 18)

__device__ __forceinline__ unsigned xb_ld(unsigned* p)              { return __hip_atomic_load(p, __ATOMIC_RELAXED, __HIP_MEMORY_SCOPE_AGENT); }
__device__ __forceinline__ unsigned xb_add(unsigned* p, unsigned v) { return __hip_atomic_fetch_add(p, v, __ATOMIC_RELAXED, __HIP_MEMORY_SCOPE_AGENT); }
__device__ __forceinline__ unsigned xb_xcc_id() { return (unsigned)__builtin_amdgcn_s_getreg((3 << 11) | 20) & 0xFu; }
#define XB_SPIN(cond, bar) do { unsigned _sp = 0; while (cond) { __builtin_amdgcn_s_sleep(1); \
    if ((++_sp & 255u) == 0u) { if (xb_ld(&(bar)[XB_TMO])) break; if (_sp > XB_SPIN_CAP) { atomicAdd(&(bar)[XB_TMO], 1u); break; } } } } while (0)

struct XcdBarrier {
    unsigned* bar; unsigned x;
    volatile LAS unsigned* st;
};

__device__ __forceinline__ XcdBarrier xcd_barrier_post(unsigned* bar, volatile LAS unsigned* st, int tid) {
    XcdBarrier b; b.bar = bar; b.x = xb_xcc_id(); b.st = st;
    if (tid == 0) (void)xb_add(&bar[XB_XCNT(b.x)], 1u);
    return b;
}
__device__ __forceinline__ void xcd_barrier_complete(unsigned* bar, unsigned x, unsigned& nloc, unsigned& nx) {
    const unsigned G = GRID;
    unsigned sum, cnt, mine, sp = 0u;
    for (;;) {
        sum = 0u; cnt = 0u; mine = 0u;
#pragma unroll
        for (unsigned j = 0; j < 16; ++j) { const unsigned c = xb_ld(&bar[XB_XCNT(j)]); sum += c; cnt += (c > 0u) ? 1u : 0u; mine = (j == x) ? c : mine; }
        if (sum == G) break;
        __builtin_amdgcn_s_sleep(1);
        if ((++sp & 255u) == 0u) { if (xb_ld(&bar[XB_TMO])) break; if (sp > XB_SPIN_CAP) { atomicAdd(&bar[XB_TMO], 1u); break; } }
    }
    nloc = mine > 0u ? mine : 1u; nx = cnt > 0u ? cnt : 1u;
}

__device__ __forceinline__ void xcd_barrier(const XcdBarrier& b, int tid) {
    asm volatile("s_waitcnt vmcnt(0)" ::: "memory");
    __syncthreads();
    if (tid == 0) {
        unsigned* bar = b.bar;
        __builtin_amdgcn_s_waitcnt(0);
        unsigned nloc = b.st[0], nx = b.st[1];
        if (nloc == 0u) { xcd_barrier_complete(bar, b.x, nloc, nx); b.st[0] = nloc; b.st[1] = nx; }
        const unsigned old = xb_add(&bar[XB_XSUB(b.x)], 1u);
        const unsigned gen = old / nloc;
        if (old + 1u == (gen + 1u) * nloc) {
            __builtin_amdgcn_fence(__ATOMIC_RELEASE, "agent");
            asm volatile("s_waitcnt vmcnt(0)" ::: "memory");
            const unsigned og = xb_add(&bar[XB_TOP], 1u);
            const unsigned tg = og / nx;
            if (og + 1u == (tg + 1u) * nx) xb_add(&bar[XB_TOPGEN], 1u);
            else XB_SPIN(xb_ld(&bar[XB_TOPGEN]) == tg, bar);
            __builtin_amdgcn_fence(__ATOMIC_ACQUIRE, "agent");
            xb_add(&bar[XB_XGEN(b.x)], 1u);
            asm volatile("s_waitcnt vmcnt(0)" ::: "memory");
        } else {
            XB_SPIN(xb_ld(&bar[XB_XGEN(b.x)]) == gen, bar);
            __builtin_amdgcn_fence(__ATOMIC_ACQUIRE, "agent");
            asm volatile("s_waitcnt vmcnt(0)" ::: "memory");
        }
    }
    __syncthreads();
}
}
#ifndef FAST_ATTN
#define FAST_ATTN 1
#endif

namespace {
constexpr int NPHASES = 2 + 9 * DEPTH;
__global__ void __launch_bounds__(NTHREADS, 2) fwd(Args args) {
    extern __shared__ __attribute__((aligned(16))) unsigned char lds_raw[];
    Frame F;
    F.lds = (LAS unsigned char*)lds_raw;
    F.wave = __builtin_amdgcn_readfirstlane(threadIdx.x >> 6);
    F.G = GRID; { const int bx = blockIdx.x; F.vcu = (bx % 8) * (GRID / 8) + bx / 8; }
    volatile LAS unsigned* MISC = (volatile LAS unsigned*)(F.lds + LDS_BYTES - 128);
    { int l0_; asm volatile("v_mbcnt_lo_u32_b32 %0, -1, 0\n\tv_mbcnt_hi_u32_b32 %0, -1, %0" : "=v"(l0_)); if (F.wave == 0 && l0_ < 32) MISC[l0_] = 0u; }
    __syncthreads();
    XcdBarrier bar;
    { int l0_; asm volatile("v_mbcnt_lo_u32_b32 %0, -1, 0\n\tv_mbcnt_hi_u32_b32 %0, -1, %0" : "=v"(l0_));
      bar = xcd_barrier_post((unsigned*)(args.ws + WS_CTL) + 4096, MISC + 8, F.wave * 64 + l0_); }
    if (args.ph_lo < 0) cooperative_groups::this_grid().sync();
    for (int ph = args.ph_lo; ph < args.ph_hi; ++ph) {
#ifndef PROBE_DUP
#define PROBE_DUP(ph) 0
#endif
      for (int rep_ = 0; rep_ < (PROBE_DUP(ph) ? 2 : 1); ++rep_) {
        if (ph > args.ph_lo || rep_ > 0) { int l0_; asm volatile("v_mbcnt_lo_u32_b32 %0, -1, 0\n\tv_mbcnt_hi_u32_b32 %0, -1, %0" : "=v"(l0_)); xcd_barrier(bar, F.wave * 64 + l0_);
#ifdef PROBE_BAR2
          xcd_barrier(bar, F.wave * 64 + l0_);
#endif
        }
        ArgsP ap = (ArgsP)__builtin_amdgcn_kernarg_segment_ptr(); asm volatile("" : "+s"(ap));
        unsigned char* ws = ap->ws; F.ws = ws;
#define FRESH_TID() do { int l_; asm volatile("v_mbcnt_lo_u32_b32 %0, -1, 0\n\tv_mbcnt_hi_u32_b32 %0, -1, %0" : "=v"(l_)); const int t_ = F.wave * 64 + l_; F.tid = t_; F.lane = l_; } while (0)
#ifndef EN_MASK
#define EN_MASK 63
#endif
        if (ph == 0) { FRESH_TID(); if (EN_MASK & 1) p0a(F, ap); continue; }
        if (ph == 1) { FRESH_TID(); if (EN_MASK & 2) p0b(F, ap); continue; }
        const int l = (ph - 2) / 9, sub = (ph - 2) % 9;
        const unsigned char* wl = ws + WS_W + (size_t)l * W_LAYER;
        const float* xin0 = (l == 0) ? (const float*)ap->in[0] : (const float*)ap->out;
        if ((EN_MASK & 4) && (sub == 0 || sub == 7)) {
            FRESH_TID();
            const int st = 3 * l + (sub == 0 ? 0 : 2);
            pg8::Gemm g{(const pg8::bf16_t*)(ws + WS_XS), (const pg8::bf16_t*)(wl + (sub == 0 ? W_F1IN : W_F2IN)), M, 2 * DFF, D};
            pg8::StaticOrder So; So.init(M, 2 * DFF, GRID, (int)blockIdx.x);
            pg8::EpiSwiGLU E{ws, st, l * SWL + (sub == 0 ? SW_F1 : SW_F2)};
            pg8::gemm_phase<pg8::EpiSwiGLU, pg8::StaticOrder, true, true>(F.lds, g, So, E, F.tid);
        } else if ((EN_MASK & 8) && (sub == 1 || sub == 8)) {
            FRESH_TID();
            const int nst = 3 * l + (sub == 1 ? 1 : 3);
            pg8::Gemm g{(const pg8::bf16_t*)(ws + WS_HMID), (const pg8::bf16_t*)(wl + (sub == 1 ? W_F1OUT : W_F2OUT)), M, D, DFF};
            pg8::StaticOrder So; So.init(M, D, GRID, (int)blockIdx.x);
            pg8::EpiResid E{(sub == 1) ? xin0 : (const float*)ap->out, ap->out, ws, l * NB * MODW + (sub == 1 ? 2 : 8) * D, 0.5f, (nst < 6) ? nst : -1};
            pg8::gemm_phase<pg8::EpiResid, pg8::StaticOrder, true, true>(F.lds, g, So, E, F.tid);
        } else if ((EN_MASK & 16) && sub == 2) {
            FRESH_TID();
            pg8::Gemm g{(const pg8::bf16_t*)(ws + WS_XS), (const pg8::bf16_t*)(wl + W_MIXIN), M, 3072, D};
            pg8::StaticOrder So; So.init(M, 3072, GRID, (int)blockIdx.x);
            pg8::EpiMixIn E{ws, (const float*)ap->in[10] + l * 64, (const float*)ap->in[11] + l * 64, l, QSCALE};
            pg8::gemm_phase<pg8::EpiMixIn, pg8::StaticOrder, true, true>(F.lds, g, So, E, F.tid);
        } else if (sub == 3) {
            FRESH_TID();
#ifndef PROBE_LOCAL_REP
#define PROBE_LOCAL_REP 1
#endif
#ifndef PROBE_CONV_REP
#define PROBE_CONV_REP 1
#endif
            for (int u = F.vcu; u < 512; u += GRID) { if (u < 256) { for (int q_ = 0; q_ < PROBE_LOCAL_REP; ++q_) gla_local_unit(F, ap, l, u); } else { for (int q_ = 0; q_ < PROBE_CONV_REP; ++q_) conv_unit(F, ap, l, u - 256); } }
        } else if (sub == 4) {
            FRESH_TID();
            for (int u = F.vcu; u < 128; u += GRID) gla_scan_unit(F, u);
#ifndef FAST_ATTN
#define FAST_ATTN 1
#endif
#if FAST_ATTN
            { const attn_body::AttnTensors AT{(const attn_body::bf16*)(ws + WS_QB), (const attn_body::bf16*)(ws + WS_KB), (const attn_body::bf16*)(ws + WS_VB), (attn_body::bf16*)(ws + WS_CONCAT), (const float*)(ws + WS_KMEAN) + (size_t)l * 32768};
              const attn_body::StaticOrder So(GRID, (int)blockIdx.x);
              __syncthreads();
              attn_body::attn_phase<attn_body::StaticOrder>((char*)lds_raw, AT, So, F.wave); }
#endif
        } else if (sub == 5) {
            FRESH_TID();
#ifndef PROBE_OUT_REP
#define PROBE_OUT_REP 1
#endif
            for (int u = F.vcu; u < 256; u += GRID) for (int q_ = 0; q_ < PROBE_OUT_REP; ++q_) gla_out_unit(F, ap, l, u);
        } else if ((EN_MASK & 32) && sub == 6) {
            FRESH_TID();
            const int nst = 3 * l + 2;
            pg8::Gemm g{(const pg8::bf16_t*)(ws + WS_CONCAT), (const pg8::bf16_t*)(wl + W_MIXOUT), M, D, D};
            pg8::StaticOrder So; So.init(M, D, GRID, (int)blockIdx.x);
            pg8::EpiResid E{(const float*)ap->out, ap->out, ws, l * NB * MODW + 5 * D, 1.0f, nst};
            pg8::gemm_phase<pg8::EpiResid, pg8::StaticOrder, true, true>(F.lds, g, So, E, F.tid);
        }
      }
    }
}

__global__ void norm_xs_kernel(const float* x, const float* gp, bf16* XS, float* rowss) {
    const int row = blockIdx.x * 4 + (threadIdx.x >> 6), lane = threadIdx.x & 63, b = row / S;
    float ss = 0.f;
    for (int j = 0; j < 16; ++j) { const int c = lane + 64 * j; const float v = x[(size_t)row * D + c]; ss += v * v; XS[(size_t)row * D + c] = (bf16)f2bf(v * gp[b * D + c]); }
    ss = wave_sum(ss); if (lane == 0) rowss[row] = ss;
}
__global__ void norm_mod_kernel(const float* x, const float* gain, const float* shift, const float* scale, bf16* h) {
    const int row = blockIdx.x * 4 + (threadIdx.x >> 6), lane = threadIdx.x & 63, b = row / S;
    const float* xr = x + (size_t)row * D;
    float v[16], ss = 0.f;
#pragma unroll
    for (int j = 0; j < 16; ++j) { v[j] = xr[lane + 64 * j]; ss += v[j] * v[j]; }
    ss = wave_sum(ss);
    const float r = rsqrtf(ss / D + EPS);
#pragma unroll
    for (int j = 0; j < 16; ++j) { const int c = lane + 64 * j; h[(size_t)row * D + c] = (bf16)f2bf(v[j] * r * gain[c] * (1.f + scale[b * MODW + c]) + shift[b * MODW + c]); }
}
struct ProjDst { bf16 *QB, *KB, *VB, *BU, *CQ, *CK, *CV, *CR; float* CG; };
template <int EPI>
__global__ void gemm_kernel(const bf16* A, const float* B, float* C, int N, int K, int ldb, const float* gate, float coef, ProjDst pd) {
    __shared__ float As[16][65];
    __shared__ float Bs[16][64];
    const int tid = threadIdx.x, tx = tid & 15, ty = tid >> 4;
    const int m0 = blockIdx.y * 64, n0 = blockIdx.x * 64;
    float acc[4][4] = {};
    for (int k0 = 0; k0 < K; k0 += 16) {
#pragma unroll
        for (int i = 0; i < 4; ++i) { const int e = tid + 256 * i, r = e >> 4, kk = e & 15; As[kk][r] = bf2f(A[(size_t)(m0 + r) * K + k0 + kk]); }
#pragma unroll
        for (int i = 0; i < 4; ++i) { const int e = tid + 256 * i, kk = e >> 6, cc = e & 63; const int n = n0 + cc; Bs[kk][cc] = (n < N) ? B[(size_t)(k0 + kk) * ldb + n] : 0.f; }
        __syncthreads();
#pragma unroll
        for (int kk = 0; kk < 16; ++kk) {
            float a[4], bb[4];
#pragma unroll
            for (int i = 0; i < 4; ++i) { a[i] = As[kk][ty * 4 + i]; bb[i] = Bs[kk][tx * 4 + i]; }
#pragma unroll
            for (int i = 0; i < 4; ++i)
#pragma unroll
                for (int j = 0; j < 4; ++j) acc[i][j] += a[i] * bb[j];
        }
        __syncthreads();
    }
#pragma unroll
    for (int i = 0; i < 4; ++i)
#pragma unroll
        for (int j = 0; j < 4; ++j) { const int m = m0 + ty * 4 + i, n = n0 + tx * 4 + j; if (n >= N) continue; const float v = acc[i][j];
            if (EPI == 2) { const int b = m / S; C[(size_t)m * D + n] += coef * gate[b * MODW + n] * v; }
            else {
                if (n < 512) pd.QB[(size_t)m * 512 + n] = (bf16)f2bf(v);
                else if (n < 1024) pd.KB[(size_t)m * 512 + n - 512] = (bf16)f2bf(v);
                else if (n < 1536) pd.VB[(size_t)m * 512 + n - 1024] = (bf16)f2bf(v);
                else if (n < 2048) pd.BU[(size_t)m * 512 + n - 1536] = (bf16)f2bf(v);
                else if (n < 2304) pd.CQ[(size_t)m * 256 + n - 2048] = (bf16)f2bf(v);
                else if (n < 2560) pd.CK[(size_t)m * 256 + n - 2304] = (bf16)f2bf(v);
                else if (n < 2816) pd.CV[(size_t)m * 256 + n - 2560] = (bf16)f2bf(v);
                else if (n < 3072) pd.CR[(size_t)m * 256 + n - 2816] = (bf16)f2bf(v);
                else pd.CG[(size_t)m * 16 + n - 3072] = v;
            } }
}
__global__ void cg_kernel(const bf16* XS, const float* rowss, const bf16* wcg, const float* swcg, float* CG) {
    const int row = blockIdx.x * 4 + (threadIdx.x >> 6), lane = threadIdx.x & 63, b = row / S;
    float xv[16];
#pragma unroll
    for (int q = 0; q < 16; ++q) xv[q] = bf2f(XS[(size_t)row * D + 16 * lane + q]);
    const float r = rsqrtf(rowss[row] / D + EPS);
    for (int n = 0; n < 16; ++n) { float s = 0.f;
#pragma unroll
        for (int q = 0; q < 16; ++q) s += xv[q] * bf2f(wcg[(size_t)n * D + 16 * lane + q]);
        s = wave_sum(s); if (lane == 0) CG[(size_t)row * 16 + n] = r * s + swcg[b * 16 + n]; }
}
__global__ void glu_kernel(const bf16* BU, bf16* HGLU) {
    const int i = blockIdx.x * 256 + threadIdx.x; const int row = i >> 8, c = i & 255;
    HGLU[i] = (bf16)f2bf(bf2f(BU[(size_t)row * 512 + c]) * sigmoid_f(bf2f(BU[(size_t)row * 512 + 256 + c])));
}
__global__ void qk_prep_kernel(bf16* QB, bf16* KB, const int* positions, const float* qn, const float* kn) {
    const int gw = blockIdx.x * 4 + (threadIdx.x >> 6), lane = threadIdx.x & 63;
    const int row = gw >> 4, which = (gw >> 3) & 1, h = gw & 7;
    bf16* p = (which ? KB : QB) + (size_t)row * 512 + h * 64;
    const float v = bf2f(p[lane]);
    const float ss = wave_sum(v * v);
    const float y = v * rsqrtf(ss / 64.f + EPS) * (which ? kn[lane] : qn[lane]);
    const float yp = __shfl_xor(y, 32);
    const float ang = (float)positions[row] * INV_FREQ[lane & 31];
    const float cs = cosf(ang), sn = sinf(ang);
    const float o = (lane < 32) ? (y * cs - yp * sn) : (y * cs + yp * sn);
    p[lane] = (bf16)f2bf(which ? o : o * QSCALE);
}
__global__ void kmean_kernel(const bf16* KB, float* kmean) {
    const int idx = blockIdx.x * 256 + threadIdx.x;
    const int d = idx & 63, blk = (idx >> 6) & 15, h = (idx >> 10) & 7, b = idx >> 13;
    float s = 0.f;
    for (int r = 0; r < 256; ++r) s += bf2f(KB[(size_t)(b * S + blk * 256 + r) * 512 + h * 64 + d]);
    kmean[idx] = s / 256.f;
}
__global__ void attn_kernel(const bf16* QB, const bf16* KB, const bf16* VB, const float* kmean, bf16* concat) {
    const int gw = blockIdx.x * 4 + (threadIdx.x >> 6), lane = threadIdx.x & 63;
    const int h = gw & 7, row = gw >> 3, b = row / S, t = row % S, qb = t >> 8;
    const float qd = bf2f(QB[(size_t)row * 512 + h * 64 + lane]);
    int sel[3] = {-1, -1, -1};
    {
        float g[16];
#pragma unroll
        for (int n = 0; n < 16; ++n) { const float pr = qd * kmean[((b * 8 + h) * 16 + n) * 64 + lane]; g[n] = (n < qb) ? wave_sum(pr) : -1e30f; }
#pragma unroll
        for (int s3 = 0; s3 < 3; ++s3) { float best = -3e38f; int bi = -1;
#pragma unroll
            for (int n = 0; n < 16; ++n) { const bool taken = (n == sel[0]) || (n == sel[1]) || (n == sel[2]); if (!taken && g[n] > best) { best = g[n]; bi = n; } }
            sel[s3] = bi; }
    }
    int blks[4]; bool ok[4];
    blks[0] = qb; ok[0] = true;
#pragma unroll
    for (int s3 = 0; s3 < 3; ++s3) { ok[s3 + 1] = (sel[s3] >= 0) && (sel[s3] < qb); blks[s3 + 1] = ok[s3 + 1] ? sel[s3] : 0; }
    float sc[16];
    float mx = -3e38f;
#pragma unroll
    for (int s4 = 0; s4 < 4; ++s4)
#pragma unroll
        for (int r = 0; r < 4; ++r) {
            const int key = blks[s4] * 256 + r * 64 + lane;
            const bf16* kp = KB + (size_t)(b * S + key) * 512 + h * 64;
            float dot = 0.f;
            for (int d = 0; d < 64; ++d) dot += __shfl(qd, d) * bf2f(kp[d]);
            const bool valid = ok[s4] && (s4 > 0 || key <= t);
            sc[s4 * 4 + r] = valid ? dot : -3e38f;
            mx = fmaxf(mx, sc[s4 * 4 + r]);
        }
    mx = wave_max(mx);
    float sum = 0.f;
#pragma unroll
    for (int i = 0; i < 16; ++i) { sc[i] = (sc[i] > -1e38f) ? exp2f(sc[i] - mx) : 0.f; sum += sc[i]; }
    sum = wave_sum(sum);
    float o = 0.f;
#pragma unroll
    for (int s4 = 0; s4 < 4; ++s4)
#pragma unroll
        for (int r = 0; r < 4; ++r) {
            const bf16* vp = VB + (size_t)(b * S + blks[s4] * 256 + r * 64) * 512 + h * 64 + lane;
            for (int j = 0; j < 64; ++j) o += __shfl(sc[s4 * 4 + r], j) * bf2f(vp[(size_t)j * 512]);
        }
    concat[(size_t)row * D + h * 64 + lane] = (bf16)f2bf(o / sum);
}
__global__ void conv_kernel(const bf16* HGLU, const float* cw, const float* cb, const float* ng, const float* nb, bf16* concat) {
    const int gw = blockIdx.x * 4 + (threadIdx.x >> 6), lane = threadIdx.x & 63;
    const int g = gw & 3, row = gw >> 2, t = row % S, ch = g * 64 + lane;
    float acc = cb[ch];
    for (int j = 0; j < 31; ++j) { const int tt = t - 30 + j; if (tt < 0) continue; acc += cw[j * 256 + ch] * bf2f(HGLU[(size_t)(row - 30 + j) * 256 + ch]); }
    const float mu = wave_sum(acc) / 64.f;
    const float xc = acc - mu;
    const float var = wave_sum(xc * xc) / 64.f;
    const float y = xc * rsqrtf(var + EPS) * ng[ch] + nb[ch];
    concat[(size_t)row * D + 512 + ch] = (bf16)f2bf(silu_f(y));
}
__global__ void gla_kernel(const float* CG, const bf16* CQ, const bf16* CK, const bf16* CV, const float* gw_, const float* gb, float* graw) {
    const int gwv = blockIdx.x * 4 + (threadIdx.x >> 6), lane = threadIdx.x & 63;
    const int e = gwv & 63, h = (gwv >> 6) & 3, b = gwv >> 8;
    float wcol[16];
#pragma unroll
    for (int r = 0; r < 16; ++r) wcol[r] = gw_[r * 256 + h * 64 + lane];
    const float bias = gb[h * 64 + lane];
    float st = 0.f;
    for (int t = 0; t < S; ++t) {
        const size_t row = (size_t)b * S + t;
        float z = bias;
#pragma unroll
        for (int r = 0; r < 16; ++r) z += CG[row * 16 + r] * wcol[r];
        const float ls = fminf(z, 0.f) - log1pf(expf(-fabsf(z)));
        const float dec = expf(ls / 16.f);
        st = dec * st + bf2f(CK[row * 256 + h * 64 + lane]) * bf2f(CV[row * 256 + h * 64 + e]);
        const float o = wave_sum(bf2f(CQ[row * 256 + h * 64 + lane]) * 0.125f * st);
        if (lane == 0) graw[row * 256 + h * 64 + e] = o;
    }
}
__global__ void gla_post_kernel(const float* graw, const bf16* CR, const float* gn, bf16* concat) {
    const int gw = blockIdx.x * 4 + (threadIdx.x >> 6), lane = threadIdx.x & 63;
    const int h = gw & 3, row = gw >> 2;
    const float v = graw[(size_t)row * 256 + h * 64 + lane];
    const float ss = wave_sum(v * v);
    const float y = v * rsqrtf(ss / 64.f + EPS) * gn[lane];
    concat[(size_t)row * D + 768 + h * 64 + lane] = (bf16)f2bf(y * silu_f(bf2f(CR[(size_t)row * 256 + h * 64 + lane])));
}
}

#ifndef FAST_MIXIN
#define FAST_MIXIN 1
#endif
static void launch_fwd(Args a, int lo, int hi, hipStream_t stream) {
    a.ph_lo = lo; a.ph_hi = hi;
    hipLaunchKernelGGL(fwd, dim3(GRID), dim3(NTHREADS), LDS_BYTES, stream, a);
}
extern "C" void kernel_launch(void* const* d_in, const int* in_sizes, int n_in, void* d_out, int out_size, void* d_ws, size_t ws_size, hipStream_t stream) {
    static int ready = 0;
    if (!ready) {
        if (n_in != 23 || ws_size < WS_END || out_size != M * D) { fprintf(stderr, "kernel_launch: unexpected shapes (n_in %d ws %zu out %d)\n", n_in, ws_size, out_size); ready = -1; return; }
        if (hipFuncSetAttribute((const void*)fwd, hipFuncAttributeMaxDynamicSharedMemorySize, LDS_BYTES) != hipSuccess) { fprintf(stderr, "kernel_launch: hipFuncSetAttribute failed\n"); ready = -1; return; }
        { int dev = 0, cus = 0, per_cu = 0; (void)hipGetDevice(&dev); (void)hipDeviceGetAttribute(&cus, hipDeviceAttributeMultiprocessorCount, dev);
          (void)hipOccupancyMaxActiveBlocksPerMultiprocessor(&per_cu, (const void*)fwd, NTHREADS, LDS_BYTES);
          if (cus * per_cu < GRID) { fprintf(stderr, "kernel_launch: grid of %d workgroups is not co-resident (CUs %d x %d per CU)\n", GRID, cus, per_cu); ready = -1; return; } }
        ready = 1;
    }
    if (ready < 0) return;
    Args a{};
    for (int i = 0; i < 23; ++i) a.in[i] = d_in[i];
    a.out = (float*)d_out; a.ws = (unsigned char*)d_ws;
    unsigned char* ws = (unsigned char*)d_ws;
    (void)hipMemsetAsync(ws + WS_CTL, 0, CTL_ZERO_BYTES, stream);
#ifndef ONE_LAUNCH
#define ONE_LAUNCH 1
#endif
#if ONE_LAUNCH
    a.ph_lo = 0; a.ph_hi = NPHASES;
    { void* kargs[] = {&a};
      hipError_t e = hipLaunchCooperativeKernel((const void*)fwd, dim3(GRID), dim3(NTHREADS), kargs, LDS_BYTES, stream);
      if (e != hipSuccess) fprintf(stderr, "kernel_launch: cooperative launch failed: %s\n", hipGetErrorString(e)); }
    return;
#endif
    launch_fwd(a, 0, 1, stream);
    launch_fwd(a, 1, 2, stream);
    float* X = (float*)d_out;
    const float* MOD = (const float*)(ws + WS_MOD); const float* GP = (const float*)(ws + WS_GP); float* ROWSS = (float*)(ws + WS_ROWSS);
    bf16* XS = (bf16*)(ws + WS_XS); bf16* CONCAT = (bf16*)(ws + WS_CONCAT);
    ProjDst pd{(bf16*)(ws + WS_QB), (bf16*)(ws + WS_KB), (bf16*)(ws + WS_VB), (bf16*)(ws + WS_KV), (bf16*)(ws + WS_CQ), (bf16*)(ws + WS_CK), (bf16*)(ws + WS_CV), (bf16*)(ws + WS_CR), (float*)(ws + WS_CG)};
    for (int l = 0; l < DEPTH; ++l) {
        const int base = 2 + 9 * l;
        const float* mod = MOD + (size_t)l * NB * MODW;
        launch_fwd(a, base + 0, base + 1, stream);
        launch_fwd(a, base + 1, base + 2, stream);
        float* KMEAN = (float*)(ws + WS_KMEAN) + (size_t)l * 32768;
#if FAST_MIXIN
        launch_fwd(a, base + 2, base + 3, stream);
        cg_kernel<<<M / 4, 256, 0, stream>>>(XS, ROWSS + (size_t)(3 * l + 1) * M, (const bf16*)(ws + WS_WCG) + (size_t)l * 16 * D, (const float*)(ws + WS_SW) + (size_t)l * SWL + SW_CG, pd.CG);
#else
        norm_mod_kernel<<<M / 4, 256, 0, stream>>>(X, (const float*)d_in[8] + l * D, mod + 3 * D, mod + 4 * D, XS);
        gemm_kernel<0><<<dim3((INW + 63) / 64, M / 64), 256, 0, stream>>>(XS, (const float*)d_in[9] + (size_t)l * D * INW, nullptr, INW, D, INW, nullptr, 0.f, pd);
        glu_kernel<<<M * 256 / 256, 256, 0, stream>>>(pd.BU, (bf16*)(ws + WS_HGLU));
        qk_prep_kernel<<<M * 16 / 4, 256, 0, stream>>>(pd.QB, pd.KB, (const int*)d_in[2], (const float*)d_in[10] + l * 64, (const float*)d_in[11] + l * 64);
        kmean_kernel<<<NB * 8 * 16 * 64 / 256, 256, 0, stream>>>(pd.KB, KMEAN);
#endif
#if !FAST_ATTN
        attn_kernel<<<M * 8 / 4, 256, 0, stream>>>(pd.QB, pd.KB, pd.VB, KMEAN, CONCAT);
#endif
#ifndef FAST_MIXERS
#define FAST_MIXERS 1
#endif
#if FAST_MIXERS
        launch_fwd(a, base + 3, base + 4, stream);
        launch_fwd(a, base + 4, base + 5, stream);
        launch_fwd(a, base + 5, base + 6, stream);
        launch_fwd(a, base + 6, base + 7, stream);
#else
        conv_kernel<<<M * 4 / 4, 256, 0, stream>>>((const bf16*)(ws + WS_HGLU), (const float*)d_in[12] + (size_t)l * 31 * 256, (const float*)d_in[13] + l * 256, (const float*)d_in[14] + l * 256, (const float*)d_in[15] + l * 256, CONCAT);
        gla_kernel<<<NB * 4 * 64 / 4, 256, 0, stream>>>(pd.CG, pd.CQ, pd.CK, pd.CV, (const float*)d_in[16] + (size_t)l * 16 * 256, (const float*)d_in[17] + l * 256, (float*)(ws + WS_KV));
        gla_post_kernel<<<M * 4 / 4, 256, 0, stream>>>((const float*)(ws + WS_KV), pd.CR, (const float*)d_in[18] + l * 64, CONCAT);
        gemm_kernel<2><<<dim3(D / 64, M / 64), 256, 0, stream>>>(CONCAT, (const float*)d_in[19] + (size_t)l * D * D, X, D, D, D, mod + 5 * D, 1.0f, pd);
        norm_xs_kernel<<<M / 4, 256, 0, stream>>>(X, GP + (size_t)(3 * l + 2) * NB * D, XS, ROWSS + (size_t)(3 * l + 2) * M);
#endif
        launch_fwd(a, base + 7, base + 8, stream);
        launch_fwd(a, base + 8, base + 9, stream);
    }
}
```

```cpp
#include <hip/hip_runtime.h>
#include <cstdio>
#include <cstdint>
#include <cmath>
#include <hip/hip_bf16.h>
#include <hip/hip_cooperative_groups.h>
namespace {
constexpr int D = 1024, NB = 4, S = 4096, M = NB * S, DEPTH = 2;
constexpr int DFF = 2816, INW = 3088, NMOD = 9, MODW = NMOD * D;
constexpr int OFF_Q = 0, OFF_K = 512, OFF_V = 1024, OFF_BU = 1536, OFF_CQ = 2048, OFF_CK = 2304, OFF_CV = 2560, OFF_CR = 2816, OFF_CG = 3072;
constexpr float EPS = 1e-6f;
constexpr float QSCALE = 0.125f * 1.4426950408889634f;
constexpr int NWAVES = 8, NTHREADS = 512, GRID = 256;
constexpr int LDS_BYTES = 147456;

constexpr size_t MiB = 1u << 20;
constexpr size_t WS_CTL = 0, CTL_ZERO_BYTES = 32768;
constexpr size_t WS_MOD = 1 * MiB;
constexpr size_t WS_GP = 1 * MiB + 512 * 1024;
constexpr size_t WS_SW = 2 * MiB;
constexpr int SW_F1 = 0, SW_MIX = 4 * 5632, SW_CG = SW_MIX + 4 * 3072, SW_F2 = SW_CG + 64, SWL = SW_F2 + 4 * 5632;
constexpr size_t WS_ROWSS = 3 * MiB;
constexpr size_t WS_KMEAN = 3 * MiB + 512 * 1024;
constexpr size_t WS_ROPEC = 4 * MiB, WS_ROPES = 6 * MiB;
constexpr size_t WS_CG = 8 * MiB;
constexpr size_t WS_DEC = 9 * MiB;
constexpr size_t WS_WCG = 10 * MiB;
constexpr size_t WS_W = 16 * MiB, W_LAYER = 41 * MiB;
constexpr size_t W_F1IN = 0, W_F1OUT = 11 * MiB, W_MIXIN = 16 * MiB + 512 * 1024, W_MIXOUT = 22 * MiB + 512 * 1024, W_F2IN = 24 * MiB + 512 * 1024, W_F2OUT = 35 * MiB + 512 * 1024;
constexpr size_t WS_XS = 100 * MiB;
constexpr size_t WS_HMID = 132 * MiB;
constexpr size_t WS_QB = 132 * MiB, WS_KB = 148 * MiB, WS_VB = 164 * MiB, WS_HGLU = 180 * MiB, WS_CQ = 188 * MiB, WS_CK = 196 * MiB, WS_CV = 204 * MiB, WS_CR = 212 * MiB;
constexpr size_t WS_CONCAT = 220 * MiB;
constexpr size_t WS_KV = 252 * MiB;
constexpr size_t WS_SPT = 268 * MiB;
constexpr size_t WS_END = 276 * MiB;


template <int CTRL> __device__ __forceinline__ float dpp_f(float v) { return __builtin_bit_cast(float, __builtin_amdgcn_update_dpp(0, __builtin_bit_cast(int, v), CTRL, 0xF, 0xF, true)); }
__device__ __forceinline__ float add_x1(float v) { return v + dpp_f<0xB1>(v); }
__device__ __forceinline__ float add_x2(float v) { return v + dpp_f<0x4E>(v); }
__device__ __forceinline__ float row16_sum(float v) { v = add_x1(v); v = add_x2(v); v += dpp_f<0x141>(v); v += dpp_f<0x140>(v); return v; }
__device__ __forceinline__ float add_x16(float v) { const unsigned u = __builtin_bit_cast(unsigned, v); auto r = __builtin_amdgcn_permlane16_swap(u, u, false, false); return __builtin_bit_cast(float, (unsigned)r[0]) + __builtin_bit_cast(float, (unsigned)r[1]); }
__device__ __forceinline__ float add_x32(float v) { const unsigned u = __builtin_bit_cast(unsigned, v); auto r = __builtin_amdgcn_permlane32_swap(u, u, false, false); return __builtin_bit_cast(float, (unsigned)r[0]) + __builtin_bit_cast(float, (unsigned)r[1]); }
}
namespace pg8 {
#define PG8_LAS __attribute__((address_space(3)))
typedef unsigned short bf16_t;
typedef short bf16x8 __attribute__((ext_vector_type(8)));
typedef float f32x4 __attribute__((ext_vector_type(4)));
typedef unsigned u32x4 __attribute__((ext_vector_type(4)));
constexpr int BM = 256, BK = 64, HALF = 128, HTB = HALF * BK * 2  , STAGE_BYTES = 8 * HTB, NXCD = 8, WGM = 8;

__host__ __device__ __forceinline__ int lds_byte(int r, int c) { const int st = (r >> 4) * 2 + (c >> 5), rr = r & 15, cc = c & 31, ob = rr * 64 + cc * 2; return st * 1024 + (ob ^ (((ob >> 9) & 1) << 5)); }
__host__ __device__ __forceinline__ void stage_rc(int b, int& R, int& C) { const int st = b / 1024, sb = b % 1024, swz = sb ^ (((sb >> 9) & 1) << 5); R = (st >> 1) * 16 + swz / 64; C = (st & 1) * 32 + (swz % 64) / 2; }
__host__ __device__ __forceinline__ int perm32(int rho) { const int n = rho >> 4, i = rho & 15; return 8 * (i >> 2) + 4 * n + (i & 3); }

struct Unit { int pm, pn; };
struct Gemm { const bf16_t* A; const bf16_t* Bt; int M, N, K; };

struct StaticOrder {
    int nM, nN, nwg, G, c;
    __host__ __device__ void init(int M, int N, int G_, int c_) { nM = M / BM; nN = N / BM; nwg = nM * nN; G = G_; c = c_; }
    __host__ __device__ bool next(int i, Unit& u) const {
        const long L = (long)i * G + c; if (L >= nwg) return false;
        int wgid = (int)L; { const int q = nwg / NXCD, r = nwg % NXCD, xcd = wgid % NXCD, off = wgid / NXCD; wgid = (xcd < r ? xcd * (q + 1) : r * (q + 1) + (xcd - r) * q) + off; }
        const int nig = WGM * nN, gid = wgid / nig, fm = gid * WGM, gsz = (nM - fm) < WGM ? (nM - fm) : WGM;
        u.pm = fm + ((wgid % nig) % gsz); u.pn = (wgid % nig) / gsz; return true;
    }
    __device__ __forceinline__ void a_ready(const Unit&) const {}
    __device__ __forceinline__ void done(const Unit&) const {}
};

__device__ __forceinline__ unsigned cvt_pk_bf16(float lo, float hi) { unsigned r; asm volatile("v_cvt_pk_bf16_f32 %0, %1, %2" : "=v"(r) : "v"(lo), "v"(hi)); return r; }

typedef unsigned u32x2 __attribute__((ext_vector_type(2)));
constexpr float EPI_EPS = 1e-6f;
__device__ __forceinline__ float sigmoid_fast(float v) { return __builtin_amdgcn_rcpf(1.f + __builtin_amdgcn_exp2f(-1.4426950408889634f * v)); }
#ifndef EPI_WT
#define EPI_WT 0
#endif
__device__ __forceinline__ void st16(void* p, u32x4 v) {
#if EPI_WT
    asm volatile("global_store_dwordx4 %0, %1, off sc1\n\ts_nop 1" :: "v"(p), "v"(v) : "memory");
#else
    *(u32x4*)p = v;
#endif
}
__device__ __forceinline__ void st16f(void* p, f32x4 v) { st16(p, __builtin_bit_cast(u32x4, v)); }
__device__ __forceinline__ u32x4 pack8(const f32x4 a, const f32x4 b) { u32x4 w; w.x = cvt_pk_bf16(a[0], a[1]); w.y = cvt_pk_bf16(a[2], a[3]); w.z = cvt_pk_bf16(b[0], b[1]); w.w = cvt_pk_bf16(b[2], b[3]); return w; }

struct EpiSwiGLU {
    static constexpr bool PERM = true, AFTER_DRAIN = false, IDEMPOTENT = true;
    unsigned char* ws; int st, swoff;
    __device__ __forceinline__ void operator()(const f32x4 (&acc)[2][2][4][2], const Unit& u, int wr, int wc, int fr_in, int fq_in) const {
        int fr = fr_in, fq = fq_in; asm volatile("" : "+v"(fr), "+v"(fq));
        const int b = u.pm >> 4; constexpr int nbt = 5632, ldh = 2816;
        bf16_t* H = (bf16_t*)(ws + WS_HMID); const float* rowss = (const float*)(ws + WS_ROWSS) + (size_t)st * 16384;
        const float* sw = (const float*)(ws + WS_SW) + swoff + (size_t)b * nbt + u.pn * BM + wc * 32 + 8 * fq;
        const f32x4 sa0 = *(const f32x4*)sw, sa1 = *(const f32x4*)(sw + 4), sb0 = *(const f32x4*)(sw + HALF), sb1 = *(const f32x4*)(sw + HALF + 4);
        const int colh = u.pn * HALF + wc * 32 + 8 * fq;
#pragma unroll
        for (int ai = 0; ai < 2; ++ai)
#pragma unroll
            for (int m = 0; m < 4; ++m) {
                const int row = u.pm * BM + ai * HALF + wr * 64 + m * 16 + fr;
                const float r = __builtin_amdgcn_rsqf(rowss[row] * (1.0f / 1024.0f) + EPI_EPS);
                f32x4 a0 = acc[ai][0][m][0] * r + sa0, a1 = acc[ai][0][m][1] * r + sa1, b0 = acc[ai][1][m][0] * r + sb0, b1 = acc[ai][1][m][1] * r + sb1;
                f32x4 o0, o1;
#pragma unroll
                for (int j = 0; j < 4; ++j) { o0[j] = a0[j] * sigmoid_fast(a0[j]) * b0[j]; o1[j] = a1[j] * sigmoid_fast(a1[j]) * b1[j]; }
                st16(H + (size_t)row * ldh + colh, pack8(o0, o1));
            }
    }
};

struct EpiResid {
    static constexpr bool PERM = true, AFTER_DRAIN = false, IDEMPOTENT = false;
    const float* xin; float* xout; unsigned char* ws; int gate_off; float coef; int nst;
    __device__ __forceinline__ void operator()(const f32x4 (&acc)[2][2][4][2], const Unit& u, int wr, int wc, int fr_in, int fq_in) const {
        int fr = fr_in, fq = fq_in; asm volatile("" : "+v"(fr), "+v"(fq));
        const int b = u.pm >> 4, col0 = u.pn * BM + wc * 32 + 8 * fq;
        const float* gate = (const float*)(ws + WS_MOD) + gate_off; const bool has_next = nst >= 0;
        const float* gp = (const float*)(ws + WS_GP) + (size_t)(has_next ? nst : 0) * 4096; float* rowss_next = (float*)(ws + WS_ROWSS) + (size_t)(has_next ? nst : 0) * 16384;
        bf16_t* XS = (bf16_t*)(ws + WS_XS); const f32x4 cv = {coef, coef, coef, coef};
        f32x4 g[2][2], p[2][2];
#pragma unroll
        for (int bj = 0; bj < 2; ++bj)
#pragma unroll
            for (int n = 0; n < 2; ++n) { g[bj][n] = *(const f32x4*)(gate + (size_t)b * 9216 + col0 + bj * HALF + 4 * n) * cv;
                p[bj][n] = *(const f32x4*)(gp + (size_t)b * 1024 + col0 + bj * HALF + 4 * n); }
#pragma unroll
        for (int ai = 0; ai < 2; ++ai)
#pragma unroll
        for (int mh = 0; mh < 2; ++mh) {
            f32x4 xo[4][2][2];
#pragma unroll
            for (int m = 2 * mh; m < 2 * mh + 2; ++m) { const size_t off = (size_t)(u.pm * BM + ai * HALF + wr * 64 + m * 16 + fr) * 1024 + col0;
#pragma unroll
                for (int bj = 0; bj < 2; ++bj)
#pragma unroll
                    for (int n = 0; n < 2; ++n) xo[m][bj][n] = *(const f32x4*)(xin + off + bj * HALF + 4 * n); }
#pragma unroll
            for (int m = 2 * mh; m < 2 * mh + 2; ++m) {
                const int row = u.pm * BM + ai * HALF + wr * 64 + m * 16 + fr;
                const size_t off = (size_t)row * 1024 + col0;
                float ssq = 0.f;
#pragma unroll
                for (int bj = 0; bj < 2; ++bj) {
                    f32x4 xn[2];
#pragma unroll
                    for (int n = 0; n < 2; ++n) { xn[n] = xo[m][bj][n] + g[bj][n] * acc[ai][bj][m][n];
                        st16f(xout + off + bj * HALF + 4 * n, xn[n]); ssq += (xn[n][0] * xn[n][0] + xn[n][1] * xn[n][1]) + (xn[n][2] * xn[n][2] + xn[n][3] * xn[n][3]); }
                    if (has_next) st16(XS + off + bj * HALF, pack8(xn[0] * p[bj][0], xn[1] * p[bj][1]));
                }
                if (has_next) { ssq = add_x16(ssq); ssq = add_x32(ssq); if (fq == 0) atomicAdd(rowss_next + row, ssq); }
            }
            asm volatile("" ::: "memory");
        }
    }
};

struct EpiMixIn {
    static constexpr bool PERM = true, AFTER_DRAIN = false, IDEMPOTENT = false;
    unsigned char* ws; const float *qn, *kn; int l; float qscale;
    __device__ __forceinline__ void operator()(const f32x4 (&acc)[2][2][4][2], const Unit& u, int wr, int wc, int fr_in, int fq_in) const {
        int fr = fr_in, fq = fq_in; asm volatile("" : "+v"(fr), "+v"(fq));
        const int b = u.pm >> 4, blk = u.pm & 15, pn = u.pn;
        const float* rowss = (const float*)(ws + WS_ROWSS) + (size_t)(3 * l + 1) * 16384;
        const float* sw = (const float*)(ws + WS_SW) + (size_t)l * SWL + SW_MIX + (size_t)b * 3072 + pn * BM + wc * 32 + 8 * fq;
        f32x4 s[2][2];
#pragma unroll
        for (int bj = 0; bj < 2; ++bj)
#pragma unroll
            for (int n = 0; n < 2; ++n) s[bj][n] = *(const f32x4*)(sw + bj * HALF + 4 * n);
        if (pn < 4) {
            const bool isk = pn >= 2; const int head = 4 * (pn & 1) + wc;
            const float* gn = isk ? kn : qn;
            f32x4 gl[2], gh[2], ks[2][2];
#pragma unroll
            for (int n = 0; n < 2; ++n) { gl[n] = *(const f32x4*)(gn + 8 * fq + 4 * n); gh[n] = *(const f32x4*)(gn + 32 + 8 * fq + 4 * n); ks[0][n] = (f32x4){0.f, 0.f, 0.f, 0.f}; ks[1][n] = (f32x4){0.f, 0.f, 0.f, 0.f}; }
            bf16_t* dstb = (bf16_t*)(ws + (isk ? WS_KB : WS_QB)) + head * 64 + 8 * fq;
            const float* ropec = (const float*)(ws + WS_ROPEC); const float* ropes = (const float*)(ws + WS_ROPES);
            const float osc = isk ? 1.0f : qscale;
#pragma unroll
            for (int ai = 0; ai < 2; ++ai)
#pragma unroll
            for (int mh = 0; mh < 2; ++mh) {
                f32x4 rc[4][2], rs[4][2]; float rr[4];
#pragma unroll
                for (int m = 2 * mh; m < 2 * mh + 2; ++m) { const int row = u.pm * BM + ai * HALF + wr * 64 + m * 16 + fr; rr[m] = rowss[row];
#pragma unroll
                    for (int n = 0; n < 2; ++n) { rc[m][n] = *(const f32x4*)(ropec + (size_t)row * 32 + 8 * fq + 4 * n); rs[m][n] = *(const f32x4*)(ropes + (size_t)row * 32 + 8 * fq + 4 * n); } }
#pragma unroll
                for (int m = 2 * mh; m < 2 * mh + 2; ++m) {
                    const int row = u.pm * BM + ai * HALF + wr * 64 + m * 16 + fr;
                    const float r = __builtin_amdgcn_rsqf(rr[m] * (1.0f / 1024.0f) + EPI_EPS);
                    f32x4 v[2][2]; float ss = 0.f;
#pragma unroll
                    for (int bj = 0; bj < 2; ++bj)
#pragma unroll
                        for (int n = 0; n < 2; ++n) { v[bj][n] = acc[ai][bj][m][n] * r + s[bj][n]; ss += (v[bj][n][0] * v[bj][n][0] + v[bj][n][1] * v[bj][n][1]) + (v[bj][n][2] * v[bj][n][2] + v[bj][n][3] * v[bj][n][3]); }
                    ss = add_x16(ss); ss = add_x32(ss);
                    const float rn = __builtin_amdgcn_rsqf(ss * (1.0f / 64.0f) + EPI_EPS);
                    f32x4 ol[2], oh[2];
#pragma unroll
                    for (int n = 0; n < 2; ++n) { const f32x4 cs = rc[m][n], sn = rs[m][n];
                        const f32x4 yl = v[0][n] * rn * gl[n], yh = v[1][n] * rn * gh[n];
                        ol[n] = (yl * cs - yh * sn) * osc; oh[n] = (yh * cs + yl * sn) * osc;
                        ks[0][n] += ol[n]; ks[1][n] += oh[n]; }
                    st16(dstb + (size_t)row * 512, pack8(ol[0], ol[1]));
                    st16(dstb + (size_t)row * 512 + 32, pack8(oh[0], oh[1]));
                }
                asm volatile("" ::: "memory");
            }
            if (isk) {
                float* km = (float*)(ws + WS_KMEAN) + (size_t)l * 32768 + ((size_t)(b * 8 + head) * 16 + blk) * 64 + 8 * fq;
#pragma unroll
                for (int bj = 0; bj < 2; ++bj)
#pragma unroll
                    for (int n = 0; n < 2; ++n)
#pragma unroll
                        for (int j = 0; j < 4; ++j) { float t = ks[bj][n][j]; t = row16_sum(t);
                            if (fr == 0) atomicAdd(km + 32 * bj + 4 * n + j, t * (1.0f / 256.0f)); }
            }
        } else if (pn == 6 || pn == 7) {
            const int colg = (pn - 6) * HALF + wc * 32 + 8 * fq;
#pragma unroll
            for (int ai = 0; ai < 2; ++ai)
#pragma unroll
                for (int m = 0; m < 4; ++m) {
                    const int row = u.pm * BM + ai * HALF + wr * 64 + m * 16 + fr;
                    const float r = __builtin_amdgcn_rsqf(rowss[row] * (1.0f / 1024.0f) + EPI_EPS);
                    f32x4 o[2];
#pragma unroll
                    for (int n = 0; n < 2; ++n) { const f32x4 a = acc[ai][0][m][n] * r + s[0][n], g = acc[ai][1][m][n] * r + s[1][n];
#pragma unroll
                        for (int j = 0; j < 4; ++j) o[n][j] = a[j] * sigmoid_fast(g[j]); }
                    st16((bf16_t*)(ws + WS_HGLU) + (size_t)row * 256 + colg, pack8(o[0], o[1]));
                }
        } else {
            bf16_t* dst; int ld;
            if (pn < 6) { dst = (bf16_t*)(ws + WS_VB) + (pn - 4) * BM; ld = 512; } else { dst = (bf16_t*)(ws + WS_CQ + (size_t)(pn - 8) * (8u << 20)); ld = 256; }
            dst += wc * 32 + 8 * fq;
#pragma unroll
            for (int ai = 0; ai < 2; ++ai)
#pragma unroll
                for (int m = 0; m < 4; ++m) {
                    const int row = u.pm * BM + ai * HALF + wr * 64 + m * 16 + fr;
                    const float r = __builtin_amdgcn_rsqf(rowss[row] * (1.0f / 1024.0f) + EPI_EPS);
#pragma unroll
                    for (int bj = 0; bj < 2; ++bj) st16(dst + (size_t)row * ld + bj * HALF, pack8(acc[ai][bj][m][0] * r + s[bj][0], acc[ai][bj][m][1] * r + s[bj][1]));
                }
        }
    }
};


template <class Epi, class Sched, bool ALIGN_EPI = false, bool SP2 = false>
__device__ __forceinline__ void gemm_phase(PG8_LAS unsigned char* lds, const Gemm g, const Sched& S, const Epi& E, const int tid_in) {
    const int tid = tid_in, wid = __builtin_amdgcn_readfirstlane(tid >> 6), lane = tid & 63, wr = wid >> 2, wc = wid & 3, fr = lane & 15, fq = lane >> 4;
    const int K = g.K, nt = K / BK;
    unsigned voffA[2], voffB[2];
#pragma unroll
    for (int i = 0; i < 2; ++i) { int R, C; stage_rc(tid * 16 + i * 8192, R, C); const int Rb = Epi::PERM ? ((R & ~31) + perm32(R & 31)) : R;
        voffA[i] = (unsigned)(R * K + C) * 2u; voffB[i] = (unsigned)(Rb * K + C) * 2u; }
    const size_t kstep = (size_t)(BK * 2);
    const size_t hstep = (size_t)HALF * K * 2;
    const size_t tstep = 2 * hstep;
    const unsigned ldsw = (unsigned)wid * 1024u;
    const int aoff = lds_byte(wr * 64 + fr, fq * 8), boff = lds_byte(wc * 32 + fr, fq * 8);
#define PG8_SA(b, h) (((b) * 2 + (h)) * HTB)
#define PG8_SB(b, h) ((4 + (b) * 2 + (h)) * HTB)
#define PG8_STAGE(bufoff, gbase, voff) do { _Pragma("unroll") for (int _i = 0; _i < 2; ++_i) \
        __builtin_amdgcn_global_load_lds((const unsigned*)((const char*)(gbase) + (voff)[_i]), (PG8_LAS unsigned*)(lds + (bufoff) + ldsw + _i * 8192), 16, 0, 0); } while (0)
#define PG8_LDA(dst, b, h) do { _Pragma("unroll") for (int m = 0; m < 4; ++m) _Pragma("unroll") for (int k = 0; k < 2; ++k) dst[m][k] = *(const PG8_LAS bf16x8*)(lds + PG8_SA(b, h) + aoff + m * 2048 + k * 1024); } while (0)
#define PG8_LDB(dst, b, h) do { _Pragma("unroll") for (int n = 0; n < 2; ++n) _Pragma("unroll") for (int k = 0; k < 2; ++k) dst[n][k] = *(const PG8_LAS bf16x8*)(lds + PG8_SB(b, h) + boff + n * 2048 + k * 1024); } while (0)
#define PG8_MMA(ai, bj, At, Bt) do { __builtin_amdgcn_s_setprio(1); _Pragma("unroll") for (int m = 0; m < 4; ++m) _Pragma("unroll") for (int n = 0; n < 2; ++n) _Pragma("unroll") for (int k = 0; k < 2; ++k) \
        acc[ai][bj][m][n] = __builtin_amdgcn_mfma_f32_16x16x32_bf16(Bt[n][k], At[m][k], acc[ai][bj][m][n], 0, 0, 0); __builtin_amdgcn_s_setprio(0); } while (0)
#define PG8_WAIT_V(n) asm volatile("s_waitcnt vmcnt(" #n ")" ::: "memory")
#define PG8_WAIT_L(n) asm volatile("s_waitcnt lgkmcnt(" #n ")" ::: "memory")
#define PG8_BAR __builtin_amdgcn_s_barrier()
#define PG8_SCHED __builtin_amdgcn_sched_barrier(0)
    Unit cur, nxt; int ui = 0;
    if (!S.next(0, cur)) return;
    f32x4 acc[2][2][4][2];
#pragma unroll
    for (int a = 0; a < 2; ++a)
#pragma unroll
        for (int b = 0; b < 2; ++b)
#pragma unroll
            for (int m = 0; m < 4; ++m)
#pragma unroll
                for (int n = 0; n < 2; ++n) acc[a][b][m][n] = (f32x4){0.f, 0.f, 0.f, 0.f};
    bf16x8 At[4][2], B0[2][2], B1[2][2];
    const char* cA = (const char*)g.A + (size_t)cur.pm * tstep; const char* cB = (const char*)g.Bt + (size_t)cur.pn * tstep;
    S.a_ready(cur);
    if constexpr (SP2) {
        PG8_STAGE(PG8_SB(0, 0), cB, voffB); PG8_STAGE(PG8_SB(0, 1), cB + hstep, voffB); PG8_STAGE(PG8_SA(0, 0), cA, voffA); PG8_STAGE(PG8_SA(0, 1), cA + hstep, voffA);
        if (wr == 1) PG8_BAR;
        PG8_WAIT_V(2); PG8_BAR;
        PG8_STAGE(PG8_SB(1, 0), cB + kstep, voffB); PG8_STAGE(PG8_SA(1, 0), cA + kstep, voffA); PG8_STAGE(PG8_SB(1, 1), cB + hstep + kstep, voffB);
        PG8_WAIT_V(6); PG8_BAR;
    } else {
        PG8_STAGE(PG8_SB(0, 0), cB, voffB); PG8_STAGE(PG8_SA(0, 0), cA, voffA); PG8_STAGE(PG8_SB(0, 1), cB + hstep, voffB); PG8_STAGE(PG8_SA(0, 1), cA + hstep, voffA);
        if (wr == 1) PG8_BAR;
        PG8_WAIT_V(4); PG8_BAR;
        PG8_STAGE(PG8_SB(1, 0), cB + kstep, voffB); PG8_STAGE(PG8_SA(1, 0), cA + kstep, voffA); PG8_STAGE(PG8_SB(1, 1), cB + hstep + kstep, voffB);
        PG8_WAIT_V(6); PG8_BAR;
    }
    for (;;) {
        const bool has_next = S.next(ui + 1, nxt);
        const char* nA = has_next ? (const char*)g.A + (size_t)nxt.pm * tstep : cA; const char* nB = has_next ? (const char*)g.Bt + (size_t)nxt.pn * tstep : cB;
        for (int t = 0; t < nt; t += 2) {
            const bool last = (t == nt - 2);
            const char* a1 = cA + (size_t)(t + 1) * kstep;
            const char* a2 = last ? nA : cA + (size_t)(t + 2) * kstep; const char* b2 = last ? nB : cB + (size_t)(t + 2) * kstep;
            const char* a3 = a2 + kstep; const char* b3 = b2 + kstep;
            if (last && has_next) S.a_ready(nxt);
            if constexpr (SP2) {
            PG8_LDB(B0, 0, 0); PG8_LDB(B1, 0, 1); PG8_SCHED; PG8_LDA(At, 0, 0); PG8_STAGE(PG8_SA(1, 1), a1 + hstep, voffA);
            PG8_WAIT_V(8); PG8_WAIT_L(0); PG8_BAR; PG8_MMA(0, 0, At, B0); PG8_MMA(0, 1, At, B1); PG8_BAR; PG8_SCHED;
            PG8_LDA(At, 0, 1); PG8_STAGE(PG8_SB(0, 0), b2, voffB); PG8_STAGE(PG8_SB(0, 1), b2 + hstep, voffB); PG8_STAGE(PG8_SA(0, 0), a2, voffA);
            PG8_WAIT_V(8); PG8_WAIT_L(0); PG8_BAR; PG8_MMA(1, 0, At, B0); PG8_MMA(1, 1, At, B1); PG8_BAR; PG8_SCHED;
            PG8_LDB(B0, 1, 0); PG8_LDB(B1, 1, 1); PG8_SCHED; PG8_LDA(At, 1, 0); PG8_STAGE(PG8_SA(0, 1), a2 + hstep, voffA);
            PG8_WAIT_V(8); PG8_WAIT_L(0); PG8_BAR; PG8_MMA(0, 0, At, B0); PG8_MMA(0, 1, At, B1); PG8_BAR; PG8_SCHED;
            PG8_LDA(At, 1, 1); PG8_STAGE(PG8_SB(1, 0), b3, voffB); PG8_STAGE(PG8_SB(1, 1), b3 + hstep, voffB); PG8_STAGE(PG8_SA(1, 0), a3, voffA);
            PG8_WAIT_V(8); PG8_WAIT_L(0); PG8_BAR; PG8_MMA(1, 0, At, B0); PG8_MMA(1, 1, At, B1); PG8_BAR; PG8_SCHED;
            } else {
            PG8_LDB(B0, 0, 0); PG8_SCHED; PG8_LDA(At, 0, 0); PG8_STAGE(PG8_SA(1, 1), a1 + hstep, voffA);
            PG8_WAIT_L(8); PG8_BAR; PG8_WAIT_L(0); PG8_MMA(0, 0, At, B0); PG8_BAR; PG8_SCHED;
            PG8_LDB(B1, 0, 1); PG8_STAGE(PG8_SB(0, 0), b2, voffB);
            PG8_BAR; PG8_WAIT_L(0); PG8_MMA(0, 1, At, B1); PG8_BAR;
            PG8_LDA(At, 0, 1); PG8_STAGE(PG8_SA(0, 0), a2, voffA);
            PG8_BAR; PG8_WAIT_L(0); PG8_MMA(1, 0, At, B0); PG8_BAR; PG8_SCHED;
            PG8_STAGE(PG8_SB(0, 1), b2 + hstep, voffB);
            PG8_WAIT_V(6); PG8_BAR; PG8_MMA(1, 1, At, B1); PG8_BAR;
            PG8_LDB(B0, 1, 0); PG8_SCHED; PG8_LDA(At, 1, 0); PG8_STAGE(PG8_SA(0, 1), a2 + hstep, voffA);
            PG8_WAIT_L(8); PG8_BAR; PG8_WAIT_L(0); PG8_MMA(0, 0, At, B0); PG8_BAR; PG8_SCHED;
            PG8_LDB(B1, 1, 1); PG8_STAGE(PG8_SB(1, 0), b3, voffB);
            PG8_BAR; PG8_WAIT_L(0); PG8_MMA(0, 1, At, B1); PG8_BAR;
            PG8_LDA(At, 1, 1); PG8_STAGE(PG8_SA(1, 0), a3, voffA);
            PG8_BAR; PG8_WAIT_L(0); PG8_MMA(1, 0, At, B0); PG8_BAR; PG8_SCHED;
            PG8_STAGE(PG8_SB(1, 1), b3 + hstep, voffB);
            PG8_WAIT_V(6); PG8_BAR; PG8_MMA(1, 1, At, B1); PG8_BAR;
            }
        }
        if constexpr (ALIGN_EPI) { if (wr == 0) PG8_BAR; }
        if constexpr (!Epi::AFTER_DRAIN) { E(acc, cur, wr, wc, fr, fq); S.done(cur); }
#ifdef PROBE_EPI2
        if constexpr (Epi::IDEMPOTENT) { asm volatile("" ::: "memory"); E(acc, cur, wr, wc, fr, fq); }
#endif
        if (!has_next) break;
#pragma unroll
        for (int a = 0; a < 2; ++a)
#pragma unroll
            for (int b = 0; b < 2; ++b)
#pragma unroll
                for (int m = 0; m < 4; ++m)
#pragma unroll
                    for (int n = 0; n < 2; ++n) acc[a][b][m][n] = (f32x4){0.f, 0.f, 0.f, 0.f};
        cur = nxt; cA = nA; cB = nB; ++ui;
        if constexpr (ALIGN_EPI) { if (wr == 1) PG8_BAR; }
    }
    PG8_WAIT_V(0);
    if constexpr (!ALIGN_EPI) { if (wr == 0) PG8_BAR; }
    PG8_BAR;
    if constexpr (Epi::AFTER_DRAIN) { E.fused(acc, cur, wr, wc, fr, fq, lds, wid, lane); S.done(cur); }
#undef PG8_SA
#undef PG8_SB
#undef PG8_STAGE
#undef PG8_LDA
#undef PG8_LDB
#undef PG8_MMA
#undef PG8_WAIT_V
#undef PG8_WAIT_L
#undef PG8_BAR
#undef PG8_SCHED
}
}

namespace {
__constant__ float INV_FREQ[32] = {0x1.000000p+0f, 0x1.7ff222p-1f, 0x1.1feb34p-1f, 0x1.afd136p-2f, 0x1.43d136p-2f, 0x1.e5a84ap-3f, 0x1.6c310ep-3f, 0x1.111aeep-3f,
    0x1.99999ap-4f, 0x1.33281ap-4f, 0x1.ccab84p-5f, 0x1.59742ap-5f, 0x1.030dc6p-5f, 0x1.84869ep-6f, 0x1.235a72p-6f, 0x1.b4f7e4p-7f,
    0x1.47ae14p-7f, 0x1.eb7360p-8f, 0x1.708938p-8f, 0x1.145ceep-8f, 0x1.9e7c70p-9f, 0x1.36d21ap-9f, 0x1.d22a50p-10f, 0x1.5d931cp-10f,
    0x1.0624dep-10f, 0x1.892918p-11f, 0x1.26d42cp-11f, 0x1.ba2e4ep-12f, 0x1.4b96c0p-12f, 0x1.f1502ap-13f, 0x1.74eea6p-13f, 0x1.17a8e4p-13f};

#define LAS __attribute__((address_space(3)))
typedef unsigned short bf16;
typedef unsigned v4u __attribute__((ext_vector_type(4)));
typedef float f32x4 __attribute__((ext_vector_type(4)));
typedef float f32x2 __attribute__((ext_vector_type(2)));
#define LDS_WAIT() asm volatile("s_waitcnt lgkmcnt(0)" ::: "memory")

__device__ __forceinline__ unsigned f2bf(float f) { unsigned u = __builtin_bit_cast(unsigned, f); return (u + 0x7fffu + ((u >> 16) & 1u)) >> 16; }
__device__ __forceinline__ unsigned pk2(float lo, float hi) { return f2bf(lo) | (f2bf(hi) << 16); }
__device__ __forceinline__ float bf2f(bf16 v) { return __builtin_bit_cast(float, (unsigned)v << 16); }
__device__ __forceinline__ float wave_sum(float v) { return add_x32(add_x16(row16_sum(v))); }
__device__ __forceinline__ float wave_max(float v) {
#pragma unroll
    for (int o = 1; o < 64; o <<= 1) v = fmaxf(v, __shfl_xor(v, o));
    return v;
}
__device__ __forceinline__ float silu_f(float v) { return v / (1.f + expf(-v)); }
__device__ __forceinline__ float sigmoid_f(float v) { return 1.f / (1.f + expf(-v)); }

struct Args { const void* in[23]; float* out; unsigned char* ws; int ph_lo, ph_hi; };
typedef const __attribute__((address_space(4))) Args* ArgsP;

struct Frame {
    LAS unsigned char* lds;
    int tid, lane, wave, vcu, G;
    unsigned char* ws;
};

__device__ __forceinline__ void tr_item(const float* W, int ldw, int K, int src_c0, bf16* WT, int c0, int k0, LAS float* scr, int lane, const float* shiftp, float* swdst, int sw_stride) {
    float tv[32];
#pragma unroll
    for (int i = 0; i < 32; ++i) tv[i] = W[(size_t)(k0 + 2 * i + (lane >> 5)) * ldw + src_c0 + (lane & 31)];
    f32x4 shv = {0.f, 0.f, 0.f, 0.f};
    if (shiftp) shv = *(const f32x4*)(shiftp + (size_t)(lane >> 4) * MODW + k0 + 4 * (lane & 15));
#pragma unroll
    for (int i = 0; i < 32; ++i) scr[(2 * i + (lane >> 5)) * 33 + (lane & 31)] = tv[i];
    LAS float* shl = scr + 2176;
    if (shiftp) *(LAS f32x4*)(shl + (lane >> 4) * 64 + 4 * (lane & 15)) = shv;
    LDS_WAIT(); asm volatile("" ::: "memory");
    const int c = lane & 7;
#pragma unroll
    for (int j = 0; j < 4; ++j) { const int n = (lane >> 3) + 8 * j; const LAS float* s = scr + (8 * c) * 33 + n;
        v4u o; o.x = pk2(s[0 * 33], s[1 * 33]); o.y = pk2(s[2 * 33], s[3 * 33]); o.z = pk2(s[4 * 33], s[5 * 33]); o.w = pk2(s[6 * 33], s[7 * 33]);
        *(v4u*)(WT + (size_t)(c0 + n) * K + k0 + 8 * c) = o; }
    if (shiftp) { const int n = lane & 31, bp = lane >> 5; float s0 = 0.f, s1 = 0.f;
#pragma unroll 4
        for (int kk = 0; kk < 64; kk += 4) { const f32x4 h0 = *(const LAS f32x4*)(shl + (2 * bp) * 64 + kk), h1 = *(const LAS f32x4*)(shl + (2 * bp + 1) * 64 + kk);
#pragma unroll
            for (int j = 0; j < 4; ++j) { const float w = scr[(kk + j) * 33 + n]; s0 += w * h0[j]; s1 += w * h1[j]; } }
        atomicAdd(swdst + (size_t)(2 * bp) * sw_stride + n, s0); atomicAdd(swdst + (size_t)(2 * bp + 1) * sw_stride + n, s1); }
    LDS_WAIT(); asm volatile("" ::: "memory");
}
__device__ __forceinline__ int src_ffn_in(int c0) { return ((c0 >> 7) & 1) * DFF + (c0 >> 8) * 128 + (c0 & 127); }
__device__ __forceinline__ int src_mix_in(int c0) {
    const int pn = c0 >> 8, cl = c0 & 255;
    if (pn < 4) { const int head = 4 * (pn & 1) + ((cl >> 5) & 3), dim = 32 * (cl >> 7) + (cl & 31); return (pn < 2 ? OFF_Q : OFF_K) + 64 * head + dim; }
    if (pn < 6) return OFF_V + (c0 - 1024);
    if (pn < 8) return OFF_BU + (cl >> 7) * 256 + 128 * (pn - 6) + (cl & 127);
    return c0;
}
constexpr int IT_FIN = 16 * 176, IT_FOUT = 44 * 32, IT_MIN = 16 * 96, IT_MOUT = 16 * 32, IT_LAYER = 2 * IT_FIN + 2 * IT_FOUT + IT_MIN + IT_MOUT;

__device__ __forceinline__ void tr_range(Frame& F, ArgsP a, int it_lo, int it_hi, int rank, int nw, bool do_sw) {
    const float* MOD = (const float*)(F.ws + WS_MOD);
    LAS float* scr = (LAS float*)(F.lds + F.wave * 16384);
    for (int it = it_lo + rank; it < it_hi; it += nw) {
        const int l = it / IT_LAYER; int r = it % IT_LAYER;
        unsigned char* wl = F.ws + WS_W + (size_t)l * W_LAYER;
        const float* modl = MOD + (size_t)l * NB * MODW; float* swl = (float*)(F.ws + WS_SW) + (size_t)l * SWL;
        if (r < IT_FIN) { const int kb = r / 176, cb = r % 176; tr_item((const float*)a->in[6] + (size_t)l * D * 2 * DFF, 2 * DFF, D, src_ffn_in(32 * cb), (bf16*)(wl + W_F1IN), 32 * cb, 64 * kb, scr, F.lane, do_sw ? modl + 0 * D : nullptr, swl + SW_F1 + 32 * cb, 5632); continue; } r -= IT_FIN;
        if (r < IT_FOUT) { const int kb = r / 32, cb = r % 32; tr_item((const float*)a->in[7] + (size_t)l * DFF * D, D, DFF, 32 * cb, (bf16*)(wl + W_F1OUT), 32 * cb, 64 * kb, scr, F.lane, nullptr, nullptr, 0); continue; } r -= IT_FOUT;
        if (r < IT_MIN) { const int kb = r / 96, cb = r % 96; tr_item((const float*)a->in[9] + (size_t)l * D * INW, INW, D, src_mix_in(32 * cb), (bf16*)(wl + W_MIXIN), 32 * cb, 64 * kb, scr, F.lane, do_sw ? modl + 3 * D : nullptr, swl + SW_MIX + 32 * cb, 3072); continue; } r -= IT_MIN;
        if (r < IT_MOUT) { const int kb = r / 32, cb = r % 32; tr_item((const float*)a->in[19] + (size_t)l * D * D, D, D, 32 * cb, (bf16*)(wl + W_MIXOUT), 32 * cb, 64 * kb, scr, F.lane, nullptr, nullptr, 0); continue; } r -= IT_MOUT;
        if (r < IT_FIN) { const int kb = r / 176, cb = r % 176; tr_item((const float*)a->in[21] + (size_t)l * D * 2 * DFF, 2 * DFF, D, src_ffn_in(32 * cb), (bf16*)(wl + W_F2IN), 32 * cb, 64 * kb, scr, F.lane, do_sw ? modl + 6 * D : nullptr, swl + SW_F2 + 32 * cb, 5632); continue; } r -= IT_FIN;
        { const int kb = r / 32, cb = r % 32; tr_item((const float*)a->in[22] + (size_t)l * DFF * D, D, DFF, 32 * cb, (bf16*)(wl + W_F2OUT), 32 * cb, 64 * kb, scr, F.lane, nullptr, nullptr, 0); }
    }
}
constexpr int TR_S1 = 5692, TR_S2 = TR_S1 + 5100, TR_S3 = TR_S2 + 5100;
static_assert(TR_S1 >= IT_FIN + IT_FOUT, "phase 2 and 3 need layer 0's FFN1 weights from phase 1");
static_assert(TR_S2 >= IT_LAYER, "phases 4..10 need all of layer 0 by the end of phase 2");
static_assert(TR_S3 >= IT_LAYER + IT_FIN + IT_FOUT, "phases 11, 12 need layer 1's FFN1 weights by the end of phase 9");
static_assert(TR_S3 <= DEPTH * IT_LAYER, "split");

__device__ __forceinline__ void p0a(Frame& F, ArgsP a) {
    const float* cvec = (const float*)a->in[1]; const int* positions = (const int*)a->in[2];
    const float* ada_w = (const float*)a->in[3]; const float* ada_b = (const float*)a->in[4];
    float* MOD = (float*)(F.ws + WS_MOD);
    {
        LAS float* sc = (LAS float*)F.lds;
        LAS float* part = (LAS float*)(F.lds + 16384);
        for (int i = F.tid; i < 4096; i += NTHREADS) sc[i] = silu_f(cvec[i]);
        __syncthreads();
        const int l = F.vcu >> 7, col0 = (F.vcu & 127) * 72;
        const bool act = F.lane < 36;
        const float* w = ada_w + (size_t)l * D * MODW + col0 + 2 * (act ? F.lane : 0);
        float acc[4][2] = {};
        const int kb = F.wave * 128;
#pragma unroll 32
        for (int k = 0; k < 128; ++k) { const f32x2 wv = *(const f32x2*)(w + (size_t)(kb + k) * MODW);
#pragma unroll
            for (int b = 0; b < 4; ++b) { const float s = sc[b * 1024 + kb + k]; acc[b][0] += s * wv.x; acc[b][1] += s * wv.y; } }
        if (act) {
#pragma unroll
            for (int b = 0; b < 4; ++b) { part[(F.wave * 4 + b) * 72 + 2 * F.lane] = acc[b][0]; part[(F.wave * 4 + b) * 72 + 2 * F.lane + 1] = acc[b][1]; } }
        __syncthreads();
        if (F.tid < 288) { const int b = F.tid / 72, col = F.tid % 72; float s = 0.f;
#pragma unroll
            for (int w8 = 0; w8 < 8; ++w8) s += part[(w8 * 4 + b) * 72 + col];
            MOD[((size_t)l * NB + b) * MODW + col0 + col] = s + ada_b[(size_t)l * MODW + col0 + col]; }
        __syncthreads();
    }
    const int gt = F.vcu * NTHREADS + F.tid, NGT = GRID * NTHREADS;
    { bf16* wcg = (bf16*)(F.ws + WS_WCG);
        for (int i = gt; i < DEPTH * 16 * 1024; i += NGT) { const int l = i >> 14, n = (i >> 10) & 15, k = i & 1023;
            wcg[i] = (bf16)f2bf(((const float*)a->in[9])[(size_t)l * D * INW + (size_t)k * INW + OFF_CG + n]); } }
    { float* rc = (float*)(F.ws + WS_ROPEC); float* rs = (float*)(F.ws + WS_ROPES);
        for (int i = gt; i < M * 32; i += NGT) { const float ang = (float)positions[i >> 5] * INV_FREQ[i & 31]; float sn, cs; sincosf(ang, &sn, &cs); rc[i] = cs; rs[i] = sn; } }
    { float* rss = (float*)(F.ws + WS_ROWSS) + M; for (int i = gt; i < 5 * M; i += NGT) rss[i] = 0.f;
      float* km = (float*)(F.ws + WS_KMEAN); for (int i = gt; i < 2 * 32768; i += NGT) km[i] = 0.f;
      float* sw = (float*)(F.ws + WS_SW); for (int i = gt; i < DEPTH * SWL; i += NGT) sw[i] = 0.f; }
}

__device__ __forceinline__ void p0b(Frame& F, ArgsP a, bool do_sw) {
    const float* MOD = (const float*)(F.ws + WS_MOD);
    const int gt = F.vcu * NTHREADS + F.tid, NGT = GRID * NTHREADS;
    const int gw = F.vcu * NWAVES + F.wave, NGW = GRID * NWAVES;
    tr_range(F, a, 0, TR_S1, gw, NGW, do_sw);
    if (gw < DEPTH * 16) { const int l = gw >> 4, n = gw & 15; const float* wg = (const float*)a->in[9] + (size_t)l * D * INW + OFF_CG + n;
        float wv[16];
#pragma unroll
        for (int q = 0; q < 16; ++q) wv[q] = wg[(size_t)(16 * F.lane + q) * INW];
#pragma unroll
        for (int b = 0; b < 4; ++b) { const float* sh = MOD + ((size_t)l * NB + b) * MODW + 3 * D + 16 * F.lane; float s = 0.f;
#pragma unroll
            for (int q = 0; q < 16; ++q) s += sh[q] * wv[q];
            s = wave_sum(s); if (F.lane == 0) ((float*)(F.ws + WS_SW))[(size_t)l * SWL + SW_CG + b * 16 + n] = s; } }
    { float* GP = (float*)(F.ws + WS_GP);
        for (int i = gt; i < 6 * 4 * 1024; i += NGT) { const int s = i >> 12, b = (i >> 10) & 3, c = i & 1023, l = s / 3, j = s % 3;
            const float* nw = (j == 0 ? (const float*)a->in[5] : (j == 1 ? (const float*)a->in[8] : (const float*)a->in[20])) + l * D;
            GP[i] = nw[c] * (1.f + MOD[((size_t)l * NB + b) * MODW + (1 + 3 * j) * D + c]); } }
    { const float* x = (const float*)a->in[0]; const float* nw = (const float*)a->in[5]; bf16* XS = (bf16*)(F.ws + WS_XS); float* rss = (float*)(F.ws + WS_ROWSS);
        for (int row0 = gw; row0 < M; row0 += 2 * NGW) {
            f32x4 v[2][4];
#pragma unroll
            for (int q2 = 0; q2 < 2; ++q2)
#pragma unroll
                for (int j = 0; j < 4; ++j) v[q2][j] = *(const f32x4*)(x + (size_t)(row0 + q2 * NGW) * D + 4 * F.lane + 256 * j);
#pragma unroll
            for (int q2 = 0; q2 < 2; ++q2) { const int row = row0 + q2 * NGW, b = row >> 12; float ss = 0.f;
#pragma unroll
                for (int j = 0; j < 4; ++j) { const int c = 4 * F.lane + 256 * j; const f32x4 vv = v[q2][j];
                    const f32x4 g = *(const f32x4*)(nw + c), sc = *(const f32x4*)(MOD + (size_t)b * MODW + D + c);
                    ss += (vv[0] * vv[0] + vv[1] * vv[1]) + (vv[2] * vv[2] + vv[3] * vv[3]);
                    const f32x4 o = vv * g * (sc + 1.f);
                    *(unsigned long long*)(XS + (size_t)row * D + c) = (unsigned long long)pk2(o[0], o[1]) | ((unsigned long long)pk2(o[2], o[3]) << 32); }
                ss = wave_sum(ss); if (F.lane == 0) rss[row] = ss; }
        } }
}
}

namespace {
typedef short s16x8 __attribute__((ext_vector_type(8)));
typedef float f32x16 __attribute__((ext_vector_type(16)));
typedef unsigned u32x2v __attribute__((ext_vector_type(2)));
__device__ __forceinline__ int crow32(int r, int hi) { return (r & 3) + 8 * (r >> 2) + 4 * hi; }
__device__ __forceinline__ float logsig16(float z) { return (fminf(z, 0.f) - __logf(1.0f + __expf(-fabsf(z)))) * (1.0f / 16.0f); }

__device__ __forceinline__ void conv_unit(Frame& F, ArgsP a, int l, int unit) {
    const bf16* HG = (const bf16*)(F.ws + WS_HGLU); bf16* CC = (bf16*)(F.ws + WS_CONCAT);
    const int b = unit >> 6, t0 = (unit & 63) * 64;
    LAS bf16* tile = (LAS bf16*)F.lds;
    for (int p = F.tid; p < 94 * 32; p += NTHREADS) { const int r = p >> 5, ch = (p & 31) * 8; const int t = t0 - 30 + r;
        v4u v = {0u, 0u, 0u, 0u}; if (t >= 0) v = *(const v4u*)(HG + ((size_t)b * S + t) * 256 + ch);
        *(LAS v4u*)(tile + r * 256 + ch) = v; }
    LAS float* wl = (LAS float*)(F.lds + 49152);
    { const float* cwg = (const float*)a->in[12] + (size_t)l * 31 * 256; for (int p = F.tid; p < 31 * 64; p += NTHREADS) *(LAS f32x4*)(wl + 4 * p) = *(const f32x4*)(cwg + 4 * p); }
    __syncthreads();
    const int c = F.tid & 255, half = F.tid >> 8;
    float w[31];
#pragma unroll
    for (int j = 0; j < 31; ++j) w[j] = wl[j * 256 + c];
    const float bias = ((const float*)a->in[13])[l * 256 + c], ng = ((const float*)a->in[14])[l * 256 + c], nb = ((const float*)a->in[15])[l * 256 + c];
    bf16* dst = CC + ((size_t)b * S + t0 + 32 * half) * D + 512 + c;
#pragma unroll 1
    for (int g = 0; g < 8; ++g) {
        const LAS bf16* tp = tile + (32 * half + 4 * g) * 256 + c;
        float xw[34];
#pragma unroll
        for (int i = 0; i < 34; ++i) xw[i] = bf2f(tp[i * 256]);
#pragma unroll
        for (int j = 0; j < 4; ++j) { float acc = bias;
#pragma unroll
            for (int tap = 0; tap < 31; ++tap) acc += w[tap] * xw[j + tap];
            const float mu = wave_sum(acc) * (1.0f / 64.0f); const float xc = acc - mu;
            const float var = wave_sum(xc * xc) * (1.0f / 64.0f);
            const float y = xc * __builtin_amdgcn_rsqf(var + EPS) * ng + nb;
            dst[(size_t)(4 * g + j) * D] = (bf16)f2bf(y * __builtin_amdgcn_rcpf(1.f + __expf(-y))); }
    }
    __syncthreads();
}

__device__ __forceinline__ void gla_ls_image(Frame& F, ArgsP a, int l, const LAS float* cg, const LAS float* gwl, LAS float* ls) {
    const int r32 = F.lane & 31, hi = F.lane >> 5, cch = 32 * F.wave + r32;
    float bcol[8];
#pragma unroll
    for (int s = 0; s < 8; ++s) bcol[s] = gwl[(2 * s + hi) * 256 + cch];
    const float gbv = ((const float*)a->in[17])[l * 256 + cch];
    f32x16 z[2];
#pragma unroll
    for (int tt = 0; tt < 2; ++tt) {
        const LAS float* cr = cg + (32 * tt + r32) * 16;
        const f32x4 c0 = *(const LAS f32x4*)cr, c1 = *(const LAS f32x4*)(cr + 4), c2 = *(const LAS f32x4*)(cr + 8), c3 = *(const LAS f32x4*)(cr + 12);
        const float ar[16] = {c0[0], c0[1], c0[2], c0[3], c1[0], c1[1], c1[2], c1[3], c2[0], c2[1], c2[2], c2[3], c3[0], c3[1], c3[2], c3[3]};
        z[tt] = (f32x16){};
#pragma unroll
        for (int s = 0; s < 8; ++s) z[tt] = __builtin_amdgcn_mfma_f32_32x32x2f32(hi ? ar[2 * s + 1] : ar[2 * s], bcol[s], z[tt], 0, 0, 0);
    }
    __syncthreads();
#pragma unroll
    for (int tt = 0; tt < 2; ++tt)
#pragma unroll
        for (int r = 0; r < 16; ++r) ls[(32 * tt + crow32(r, hi)) * 256 + cch] = logsig16(z[tt][r] + gbv);
    __syncthreads();
}

constexpr int GP72 = 72;
__device__ __forceinline__ void gla_local_unit(Frame& F, ArgsP a, int l, int unit) {
    const int b = unit >> 6, n = unit & 63; const size_t row0 = (size_t)b * S + n * 64;
    LAS float* cg = (LAS float*)F.lds;
    LAS float* gwl = (LAS float*)(F.lds + 4096);
    LAS float* part = (LAS float*)(F.lds + 20480);
    LAS float* ls = (LAS float*)F.lds;
    LAS bf16* keT = (LAS bf16*)(F.lds + 65536);
    LAS bf16* vT = (LAS bf16*)(F.lds + 65536 + 36864);
    const bf16* XS = (const bf16*)(F.ws + WS_XS); const bf16* wcg = (const bf16*)(F.ws + WS_WCG) + (size_t)l * 16 * D;
    const int c = F.tid & 255, half = F.tid >> 8;
    unsigned short kreg[32], vreg[32];
    { const bf16* CK = (const bf16*)(F.ws + WS_CK) + (row0 + 32 * half) * 256 + c; const bf16* CV = (const bf16*)(F.ws + WS_CV) + (row0 + 32 * half) * 256 + c;
#pragma unroll
        for (int i = 0; i < 32; ++i) { kreg[i] = CK[(size_t)i * 256]; vreg[i] = CV[(size_t)i * 256]; } }
    f32x4 gwr[2];
    { const float* gwg = (const float*)a->in[16] + (size_t)l * 16 * 256;
#pragma unroll
        for (int i = 0; i < 2; ++i) gwr[i] = *(const f32x4*)(gwg + 4 * (F.tid + 512 * i)); }
    {
        const int fr = F.lane & 15, fq = F.lane >> 4;
        f32x4 acc[4];
#pragma unroll
        for (int rt = 0; rt < 4; ++rt) acc[rt] = (f32x4){0.f, 0.f, 0.f, 0.f};
#pragma unroll
        for (int ks = 0; ks < 4; ++ks) { const int k0 = F.wave * 128 + ks * 32 + 8 * fq;
            const s16x8 bfr = *(const s16x8*)(wcg + (size_t)fr * D + k0);
#pragma unroll
            for (int rt = 0; rt < 4; ++rt) { const s16x8 afr = *(const s16x8*)(XS + (row0 + 16 * rt + fr) * D + k0);
                acc[rt] = __builtin_amdgcn_mfma_f32_16x16x32_bf16(afr, bfr, acc[rt], 0, 0, 0); } }
#pragma unroll
        for (int rt = 0; rt < 4; ++rt)
#pragma unroll
            for (int j = 0; j < 4; ++j) part[(F.wave * 64 + 16 * rt + 4 * fq + j) * 16 + fr] = acc[rt][j];
    }
#pragma unroll
    for (int i = 0; i < 32; i += 2) *(LAS unsigned*)(vT + c * GP72 + 32 * half + i) = (unsigned)vreg[i] | ((unsigned)vreg[i + 1] << 16);
#pragma unroll
    for (int i = 0; i < 2; ++i) *(LAS f32x4*)(gwl + 4 * (F.tid + 512 * i)) = gwr[i];
    __syncthreads();
    {
        const float* rowss = (const float*)(F.ws + WS_ROWSS) + (size_t)(3 * l + 1) * M; const float* swcg = (const float*)(F.ws + WS_SW) + (size_t)l * SWL + SW_CG + b * 16;
        float* CG = (float*)(F.ws + WS_CG);
#pragma unroll
        for (int q = 0; q < 2; ++q) { const int o = F.tid + 512 * q, tok = o >> 4, nn = o & 15; float s = 0.f;
#pragma unroll
            for (int w8 = 0; w8 < 8; ++w8) s += part[(w8 * 64 + tok) * 16 + nn];
            const float r = rsqrtf(rowss[row0 + tok] * (1.0f / 1024.0f) + EPS);
            const float v = r * s + swcg[nn]; cg[o] = v; CG[(row0 + tok) * 16 + nn] = v; }
    }
    __syncthreads();
    gla_ls_image(F, a, l, cg, gwl, ls);
    {
        float off = 0.f, tot = 0.f;
#pragma unroll 8
        for (int t = 0; t < 32; ++t) off += ls[t * 256 + c];
#pragma unroll 8
        for (int t = 32; t < 64; ++t) tot += ls[t * 256 + c];
        const float Glast = off + tot;
        float G = half ? off : 0.f;
#pragma unroll
        for (int i = 0; i < 32; i += 2) {
            G += ls[(32 * half + i) * 256 + c]; const float k0 = bf2f(kreg[i]) * __expf(Glast - G);
            G += ls[(32 * half + i + 1) * 256 + c]; const float k1 = bf2f(kreg[i + 1]) * __expf(Glast - G);
            *(LAS unsigned*)(keT + c * GP72 + 32 * half + i) = pk2(k0, k1);
        }
        if (half == 1) ((float*)(F.ws + WS_DEC))[((size_t)(b * 4 + (c >> 6)) * 64 + n) * 64 + (c & 63)] = __expf(Glast);
    }
    __syncthreads();
    {
        const int h = F.wave >> 1, et = F.wave & 1, r32 = F.lane & 31, hi = F.lane >> 5;
        float* KVT = (float*)(F.ws + WS_KV) + ((size_t)(b * 4 + h) * 64 + n) * 4096;
#pragma unroll
        for (int dt = 0; dt < 2; ++dt) { f32x16 acc = {};
#pragma unroll
            for (int ks = 0; ks < 4; ++ks) { const s16x8 af = *(const LAS s16x8*)(vT + (h * 64 + 32 * et + r32) * GP72 + 16 * ks + 8 * hi);
                const s16x8 bf = *(const LAS s16x8*)(keT + (h * 64 + 32 * dt + r32) * GP72 + 16 * ks + 8 * hi);
                acc = __builtin_amdgcn_mfma_f32_32x32x16_bf16(af, bf, acc, 0, 0, 0); }
#pragma unroll
            for (int r = 0; r < 16; ++r) KVT[(size_t)(32 * et + crow32(r, hi)) * 64 + 32 * dt + r32] = acc[r]; }
    }
    __syncthreads();
}

__device__ __forceinline__ void gla_scan_unit(Frame& F, int unit) {
    const int bh = unit >> 3, idx = (unit & 7) * 512 + F.tid, d = idx & 63;
    const float* KVT = (const float*)(F.ws + WS_KV) + (size_t)bh * 64 * 4096 + idx; const float* DEC = (const float*)(F.ws + WS_DEC) + (size_t)bh * 64 * 64 + d;
    bf16* SPT = (bf16*)(F.ws + WS_SPT) + (size_t)bh * 64 * 4096 + idx;
    float s = 0.f;
    for (int n0 = 0; n0 < 64; n0 += 8) { float kv[8], dc[8];
#pragma unroll
        for (int j = 0; j < 8; ++j) { kv[j] = KVT[(size_t)(n0 + j) * 4096]; dc[j] = DEC[(n0 + j) * 64]; }
#pragma unroll
        for (int j = 0; j < 8; ++j) { SPT[(size_t)(n0 + j) * 4096] = (bf16)f2bf(s); s = dc[j] * s + kv[j]; } }
}

__device__ __forceinline__ void gla_out_unit(Frame& F, ArgsP a, int l, int unit) {
    const int b = unit >> 6, n = unit & 63; const size_t row0 = (size_t)b * S + n * 64;
    LAS float* cg = (LAS float*)F.lds;
    LAS float* gwl = (LAS float*)(F.lds + 4096);
    LAS float* ls = (LAS float*)F.lds;
    LAS bf16* vT = (LAS bf16*)F.lds;
    LAS bf16* qt = (LAS bf16*)(F.lds + 65536);
    LAS bf16* kt = (LAS bf16*)(F.lds + 65536 + 36864);
    const int c = F.tid & 255, half = F.tid >> 8, hh = c >> 6, dd = c & 63;
    v4u qreg[4], kreg[4];
#pragma unroll
    for (int i = 0; i < 4; ++i) { const int p = F.tid + 512 * i; qreg[i] = *(const v4u*)((const bf16*)(F.ws + WS_CQ) + (row0 + (p >> 5)) * 256 + (p & 31) * 8);
        kreg[i] = *(const v4u*)((const bf16*)(F.ws + WS_CK) + (row0 + (p >> 5)) * 256 + (p & 31) * 8); }
    unsigned short vreg[32];
    { const bf16* CV = (const bf16*)(F.ws + WS_CV) + (row0 + 32 * half) * 256 + c;
#pragma unroll
        for (int i = 0; i < 32; ++i) vreg[i] = CV[(size_t)i * 256]; }
    f32x4 gwr[2]; float cgr[2];
    { const float* gwg = (const float*)a->in[16] + (size_t)l * 16 * 256; const float* CG = (const float*)(F.ws + WS_CG) + row0 * 16;
#pragma unroll
        for (int i = 0; i < 2; ++i) { gwr[i] = *(const f32x4*)(gwg + 4 * (F.tid + 512 * i)); cgr[i] = CG[F.tid + 512 * i]; } }
#pragma unroll
    for (int i = 0; i < 2; ++i) { *(LAS f32x4*)(gwl + 4 * (F.tid + 512 * i)) = gwr[i]; cg[F.tid + 512 * i] = cgr[i]; }
#pragma unroll
    for (int i = 0; i < 4; ++i) { const int p = F.tid + 512 * i, t = p >> 5, ch = (p & 31) * 8; const int o = ((ch >> 6) * 64 + t) * GP72 + (ch & 63);
        *(LAS v4u*)(qt + o) = qreg[i]; *(LAS v4u*)(kt + o) = kreg[i]; }
    __syncthreads();
    gla_ls_image(F, a, l, cg, gwl, ls);
    {
        float G = 0.f;
        if (half) {
#pragma unroll 8
            for (int t = 0; t < 32; ++t) G += ls[t * 256 + c]; }
#pragma unroll 4
        for (int i = 0; i < 32; ++i) { const int o = (hh * 64 + 32 * half + i) * GP72 + dd;
            G += ls[(32 * half + i) * 256 + c]; const float e0 = __expf(G);
            qt[o] = (bf16)f2bf(bf2f(qt[o]) * 0.125f * e0);
            kt[o] = (bf16)f2bf(bf2f(kt[o]) * __builtin_amdgcn_rcpf(e0)); }
    }
    __syncthreads();
#pragma unroll
    for (int i = 0; i < 32; i += 2) *(LAS unsigned*)(vT + c * GP72 + 32 * half + i) = (unsigned)vreg[i] | ((unsigned)vreg[i + 1] << 16);
    __syncthreads();
    const int h = F.wave >> 1, sub = F.wave & 1, r32 = F.lane & 31, hi = F.lane >> 5;
    f32x16 am[2];
#pragma unroll
    for (int mt = 0; mt < 2; ++mt) { am[mt] = (f32x16){};
#pragma unroll
        for (int ks = 0; ks < 4; ++ks) { const s16x8 af = *(const LAS s16x8*)(kt + (h * 64 + 32 * mt + r32) * GP72 + 16 * ks + 8 * hi);
            const s16x8 bf = *(const LAS s16x8*)(qt + (h * 64 + 32 * sub + r32) * GP72 + 16 * ks + 8 * hi);
            am[mt] = __builtin_amdgcn_mfma_f32_32x32x16_bf16(af, bf, am[mt], 0, 0, 0); } }
    __syncthreads();
    { const int lq = 32 * sub + r32;
#pragma unroll
        for (int mt = 0; mt < 2; ++mt)
#pragma unroll
            for (int g4 = 0; g4 < 4; ++g4) { float v[4];
#pragma unroll
                for (int j = 0; j < 4; ++j) { const int mm = 32 * mt + 8 * g4 + 4 * hi + j; v[j] = (mm <= lq) ? am[mt][4 * g4 + j] : 0.f; }
                u32x2v w; w.x = pk2(v[0], v[1]); w.y = pk2(v[2], v[3]);
                *(LAS u32x2v*)(kt + (h * 64 + lq) * GP72 + 32 * mt + 8 * g4 + 4 * hi) = w; } }
    __syncthreads();
    const bf16* SPT = (const bf16*)(F.ws + WS_SPT) + ((size_t)(b * 4 + h) * 64 + n) * 4096;
    f32x16 o[2];
#pragma unroll
    for (int et = 0; et < 2; ++et) { o[et] = (f32x16){};
#pragma unroll
        for (int ks = 0; ks < 4; ++ks) { const s16x8 af = *(const LAS s16x8*)(vT + (h * 64 + 32 * et + r32) * GP72 + 16 * ks + 8 * hi);
            const s16x8 bf = *(const LAS s16x8*)(kt + (h * 64 + 32 * sub + r32) * GP72 + 16 * ks + 8 * hi);
            o[et] = __builtin_amdgcn_mfma_f32_32x32x16_bf16(af, bf, o[et], 0, 0, 0); }
#pragma unroll
        for (int ks = 0; ks < 4; ++ks) { const s16x8 af = *(const s16x8*)(SPT + (size_t)(32 * et + r32) * 64 + 16 * ks + 8 * hi);
            const s16x8 bf = *(const LAS s16x8*)(qt + (h * 64 + 32 * sub + r32) * GP72 + 16 * ks + 8 * hi);
            o[et] = __builtin_amdgcn_mfma_f32_32x32x16_bf16(af, bf, o[et], 0, 0, 0); } }
    float ss = 0.f;
#pragma unroll
    for (int et = 0; et < 2; ++et)
#pragma unroll
        for (int r = 0; r < 16; ++r) ss += o[et][r] * o[et][r];
    ss = add_x32(ss);
    const float rn = rsqrtf(ss * (1.0f / 64.0f) + EPS);
    const size_t row = row0 + 32 * sub + r32;
    const bf16* CR = (const bf16*)(F.ws + WS_CR) + row * 256 + h * 64; bf16* CC = (bf16*)(F.ws + WS_CONCAT) + row * D + 768 + h * 64;
    const float* gn = (const float*)a->in[18] + l * 64;
#pragma unroll
    for (int et = 0; et < 2; ++et)
#pragma unroll
        for (int g4 = 0; g4 < 4; ++g4) { const int e0 = 32 * et + 8 * g4 + 4 * hi;
            const u32x2v cr = *(const u32x2v*)(CR + e0); const f32x4 gv = *(const f32x4*)(gn + e0);
            float y[4];
#pragma unroll
            for (int j = 0; j < 4; ++j) { const float crv = __builtin_bit_cast(float, (j & 1) ? ((j < 2 ? cr.x : cr.y) & 0xffff0000u) : ((j < 2 ? cr.x : cr.y) << 16));
                y[j] = o[et][4 * g4 + j] * rn * gv[j] * (crv / (1.f + __expf(-crv))); }
            u32x2v w; w.x = pk2(y[0], y[1]); w.y = pk2(y[2], y[3]);
            *(u32x2v*)(CC + e0) = w; }
    __syncthreads();
}
}
#include <hip/hip_bf16.h>
#include <cmath>
namespace attn_body {
using bf16=__hip_bfloat16;
using bf16x8=__attribute__((ext_vector_type(8)))short;
using s16x4=__attribute__((ext_vector_type(4)))short;
using f32x16=__attribute__((ext_vector_type(16)))float;
using u32x4=__attribute__((ext_vector_type(4)))unsigned;
constexpr int BATCH=4,NHEAD=8,SEQ=4096,D=64,DM=NHEAD*D,DMO=1024;
constexpr int NW=8,QBLK=32,QB=QBLK*NW,KVBLK=64,NQB=SEQ/QB;
constexpr int ATTN_PITCH=DM, ATTN_UNIT_ROWS=QB;
__device__ __forceinline__ int crow(int r,int hi){return (r&3)+8*(r>>2)+4*hi;}
#define SBAR() __builtin_amdgcn_sched_barrier(0)
__device__ __forceinline__ void cmask(f32x16&p0,f32x16&p1,int jb,int qrel,int hi){
  const float NEG=-INFINITY; int kb=64*jb+4*hi;
  #pragma unroll
  for(int r=0;r<16;++r){int kv=kb+(r&3)+8*(r>>2); if(kv>qrel)p0[r]=NEG; if(kv+32>qrel)p1[r]=NEG;}
}

__device__ __forceinline__ void smask(f32x16&p0,f32x16&p1,unsigned keep){
  const float NEG=-INFINITY;
  #pragma unroll
  for(int r=0;r<16;++r){ if(!keep){p0[r]=NEG;p1[r]=NEG;} }
}
constexpr int NSLOT=3, SLOTB=8192;
constexpr int LDS_K=0, LDS_V=NSLOT*SLOTB, LDS_WS=2*NSLOT*SLOTB, LDS_OST=LDS_WS+NW*64*4, LDS_BYTES=LDS_OST+NW*4096;
constexpr float C2=0.125f*1.4426950408889634f;
__device__ __forceinline__ void glds16(const void*gsrc,unsigned lds_dst){unsigned keep;
  asm volatile("s_mov_b32 %0, m0\n\ts_mov_b32 m0, %2\n\ts_nop 0\n\tglobal_load_lds_dwordx4 %1, off\n\ts_mov_b32 m0, %0":"=&s"(keep):"v"(gsrc),"s"(lds_dst):"memory");}
__device__ __forceinline__ float max3f(float a,float b,float c){float r;asm("v_max3_f32 %0, %1, %2, %3":"=v"(r):"v"(a),"v"(b),"v"(c));return r;}
__device__ __forceinline__ float max2f(float a,float b){float r;asm("v_max_f32_e32 %0, %1, %2":"=v"(r):"v"(a),"v"(b));return r;}
__device__ __forceinline__ float fadd_s(float a,float b){float r;asm("v_add_f32_e32 %0, %1, %2":"=v"(r):"v"(a),"v"(b));return r;}
__device__ __forceinline__ float fsub_s(float a,float b){float r;asm("v_sub_f32_e32 %0, %1, %2":"=v"(r):"v"(a),"v"(b));return r;}
typedef float f32x2_t __attribute__((ext_vector_type(2))); typedef __bf16 bf16x2_t __attribute__((ext_vector_type(2)));
__device__ __forceinline__ unsigned cvtpk_s(float lo,float hi){f32x2_t v={lo,hi};bf16x2_t b=__builtin_convertvector(v,bf16x2_t);return __builtin_bit_cast(unsigned,b);}
#define WAIT_BAR(N) asm volatile("s_waitcnt vmcnt(" #N ") lgkmcnt(0)\n\ts_barrier":::"memory")

__device__ __forceinline__ void qkt(f32x16&p0,f32x16&p1,const char*Kslot,const bf16x8*qr,const f32x16&negm,int r32,int hi){
  const char*kb=Kslot+hi*1024+r32*16;
  #pragma unroll
  for(int d0=0;d0<4;++d0){
    const bf16x8 b0=*reinterpret_cast<const bf16x8*>(kb+d0*2048);
    const bf16x8 b1=*reinterpret_cast<const bf16x8*>(kb+d0*2048+512);
    if(d0==0){p0=__builtin_amdgcn_mfma_f32_32x32x16_bf16(b0,qr[0],negm,0,0,0);p1=__builtin_amdgcn_mfma_f32_32x32x16_bf16(b1,qr[0],negm,0,0,0);}
    else{p0=__builtin_amdgcn_mfma_f32_32x32x16_bf16(b0,qr[d0],p0,0,0,0);p1=__builtin_amdgcn_mfma_f32_32x32x16_bf16(b1,qr[d0],p1,0,0,0);}}
}
typedef __attribute__((address_space(3))) const char* lds_cptr;
typedef short v4i16_t __attribute__((ext_vector_type(4)));
__device__ __forceinline__ void kload8(bf16x8*kf,lds_cptr kp){
  kf[0]=*(const __attribute__((address_space(3))) bf16x8*)(kp);      kf[1]=*(const __attribute__((address_space(3))) bf16x8*)(kp+512);
  kf[2]=*(const __attribute__((address_space(3))) bf16x8*)(kp+2048); kf[3]=*(const __attribute__((address_space(3))) bf16x8*)(kp+2560);
  kf[4]=*(const __attribute__((address_space(3))) bf16x8*)(kp+4096); kf[5]=*(const __attribute__((address_space(3))) bf16x8*)(kp+4608);
  kf[6]=*(const __attribute__((address_space(3))) bf16x8*)(kp+6144); kf[7]=*(const __attribute__((address_space(3))) bf16x8*)(kp+6656);
}
__device__ __forceinline__ void kload2(bf16x8*kf,lds_cptr kp,int j){ kf[2*j]=*(const __attribute__((address_space(3))) bf16x8*)(kp+j*2048); kf[2*j+1]=*(const __attribute__((address_space(3))) bf16x8*)(kp+j*2048+512); }
__device__ __forceinline__ s16x4 vtr(lds_cptr p){ return __builtin_bit_cast(s16x4,__builtin_amdgcn_ds_read_tr16_b64_v4i16((__attribute__((address_space(3))) v4i16_t*)p)); }
__device__ __forceinline__ float rowmax(const f32x16&p0,const f32x16&p1){
  float a=max3f(p0[0],p0[1],p1[0]),b=max3f(p0[2],p0[3],p1[1]);a=max3f(a,p1[2],p1[3]);
  #pragma unroll
  for(int r=4;r<16;r+=4){a=max3f(a,p0[r],p0[r+1]);b=max3f(b,p0[r+2],p0[r+3]);a=max3f(a,p1[r],p1[r+1]);b=max3f(b,p1[r+2],p1[r+3]);}
  const float m=max2f(a,b);
  auto rr=__builtin_amdgcn_permlane32_swap(__float_as_uint(m),__float_as_uint(m),false,false);
  return max2f(__uint_as_float(rr[0]),__uint_as_float(rr[1]));
}
__device__ __forceinline__ void pv(f32x16*o,int vb,bf16x8 pa0,bf16x8 pa1,bf16x8 pa2,bf16x8 pa3){
  #pragma unroll
  for(int d0=0;d0<2;++d0){s16x4 lo[4],hi[4];
    #pragma unroll
    for(int ks=0;ks<4;++ks){
      asm volatile("ds_read_b64_tr_b16 %0,%1 offset:%c2":"=&v"(lo[ks]):"v"(vb),"i"(d0*4096+ks*1024):"memory");
      asm volatile("ds_read_b64_tr_b16 %0,%1 offset:%c2":"=&v"(hi[ks]):"v"(vb),"i"(d0*4096+ks*1024+512):"memory");}
    asm volatile("s_waitcnt lgkmcnt(0)":::"memory");SBAR();
    #define PK(k) (bf16x8){lo[k][0],lo[k][1],lo[k][2],lo[k][3],hi[k][0],hi[k][1],hi[k][2],hi[k][3]}
    o[d0]=__builtin_amdgcn_mfma_f32_32x32x16_bf16(pa0,PK(0),o[d0],0,0,0);
    o[d0]=__builtin_amdgcn_mfma_f32_32x32x16_bf16(pa1,PK(1),o[d0],0,0,0);
    o[d0]=__builtin_amdgcn_mfma_f32_32x32x16_bf16(pa2,PK(2),o[d0],0,0,0);
    o[d0]=__builtin_amdgcn_mfma_f32_32x32x16_bf16(pa3,PK(3),o[d0],0,0,0);
    #undef PK
  }
}

#ifndef ATTN_STORE16
#define ATTN_STORE16(p,v) (*(u32x4*)(p)=(v))
#endif
template<int THRL> __device__ __forceinline__ void attn_unit(int b,int h,int qb,const bf16*Q,const bf16*__restrict__ K,const bf16*__restrict__ V,bf16*O,const float*__restrict__ KM,char*shm,int tid){
  const int lane=tid&63,r32=lane&31,hi=lane>>5; const int wid=__builtin_amdgcn_readfirstlane(tid>>6);
  const long rowbase=(long)b*SEQ; const int q0=qb*QB;
  const bf16*Qw=Q+(rowbase+q0+wid*QBLK)*DM+h*D;
  const bf16*Kh=K+rowbase*DM+h*D,*Vh=V+rowbase*DM+h*D;
  const unsigned lds0=(unsigned)(uintptr_t)shm;
  float*wsf=(float*)(shm+LDS_WS)+wid*64;
  const bf16*ksrc=Kh+(long)lane*DM+wid*8;
  const bf16*vsrc=Vh+(long)(16*(wid&3)+(lane>>2))*DM+(wid>>2)*32+(lane&3)*8;
  const unsigned kdst=lds0+LDS_K+wid*1024, vdst=lds0+LDS_V+wid*1024;
  #define AT(t) (((t)<4)?(NT-4+(t)):((t)-4))
  #define DMA_K(t,slot) glds16(ksrc+(long)AT(t)*KVBLK*DM,(unsigned)__builtin_amdgcn_readfirstlane(kdst+(slot)))
  #define DMA_V(t,slot) glds16(vsrc+(long)AT(t)*KVBLK*DM,(unsigned)__builtin_amdgcn_readfirstlane(vdst+(slot)))
  const int vb0=(int)(lds0+LDS_V)+((lane>>4)&1)*32+(lane&3)*8+(4*hi+((lane&15)>>2))*64;
  const char*Kbase=shm+LDS_K; bf16x8 kf[8];
  const lds_cptr shm3=(lds_cptr)shm; const lds_cptr kp0=shm3+LDS_K+hi*1024+r32*16; const lds_cptr vp0=shm3+LDS_V+((lane>>4)&1)*32+(lane&3)*8+(4*hi+((lane&15)>>2))*64;
  const int NT=(q0+QB)/KVBLK;
  DMA_K(0,0);DMA_V(0,0);DMA_K(1,SLOTB);
  bf16x8 qr[4];
  #pragma unroll
  for(int d0=0;d0<4;++d0)qr[d0]=*reinterpret_cast<const bf16x8*>(&Qw[(long)r32*DM+d0*16+hi*8]);
  unsigned selmask=0u;
  { float b0=-INFINITY,b1=-INFINITY,b2=-INFINITY; int i0=-1,i1=-1,i2=-1;
    float qf[32];
    #pragma unroll
    for(int d0=0;d0<4;++d0){
      #pragma unroll
      for(int j=0;j<8;++j)qf[8*d0+j]=__builtin_bit_cast(float,((unsigned)(unsigned short)qr[d0][j])<<16);}
    float*kml=reinterpret_cast<float*>(shm+LDS_OST+wid*4096);
    { const float4*kmg=reinterpret_cast<const float4*>(KM+(long)(b*NHEAD+h)*16*64);
      const float4 t0=kmg[lane],t1=kmg[lane+64],t2=kmg[lane+128],t3=kmg[lane+192];
      float4*kl4=reinterpret_cast<float4*>(kml); kl4[lane]=t0; kl4[lane+64]=t1; kl4[lane+128]=t2; kl4[lane+192]=t3;
      asm volatile("s_waitcnt lgkmcnt(0)":::"memory"); }
    for(int n=0;n<qb;++n){
      const float*km=kml+n*64+8*hi; float s=0.f;
      #pragma unroll
      for(int d0=0;d0<4;++d0){ const float4 ka=*reinterpret_cast<const float4*>(km+16*d0),kb=*reinterpret_cast<const float4*>(km+16*d0+4);
        s+=qf[8*d0]*ka.x+qf[8*d0+1]*ka.y+qf[8*d0+2]*ka.z+qf[8*d0+3]*ka.w+qf[8*d0+4]*kb.x+qf[8*d0+5]*kb.y+qf[8*d0+6]*kb.z+qf[8*d0+7]*kb.w; }
      s=add_x32(s);
      const bool g0=s>b0,g1=s>b1,g2=s>b2;
      b2=g1?b1:(g2?s:b2); i2=g1?i1:(g2?n:i2);
      b1=g0?b0:(g1?s:b1); i1=g0?i0:(g1?n:i1);
      b0=g0?s:b0;         i0=g0?n:i0; }
    if(i0>=0)selmask|=1u<<i0; if(i1>=0)selmask|=1u<<i1; if(i2>=0)selmask|=1u<<i2; }
  float mhat=0.f,l_reg=0.f;f32x16 o[2];o[0]=f32x16{};o[1]=f32x16{};f32x16 negm=f32x16{};asm volatile("":"+v"(negm));
  const int qrel=wid*QBLK+r32;
  #define CMASK(P0,P1,t) do{ if((t)<4)cmask(P0,P1,(t),qrel,hi); else smask(P0,P1,(selmask>>(((t)-4)>>2))&1u); }while(0)
  bool resc=false;
  #define START(P0,P1) do{ const float rm=rowmax(P0,P1); resc=false; \
    { const float dl=rm; mhat=fadd_s(mhat,dl); \
      _Pragma("unroll") for(int r=0;r<16;++r){P0[r]=fsub_s(P0[r],dl);P1[r]=fsub_s(P1[r],dl);} \
      _Pragma("unroll") for(int r=0;r<16;++r)negm[r]=-mhat; asm volatile("":"+v"(negm)); } \
    _Pragma("unroll") for(int r=0;r<16;++r)P0[r]=__builtin_amdgcn_exp2f(P0[r]); }while(0)
  #define RESC() do{ if(resc){ asm volatile("s_waitcnt lgkmcnt(0)":::"memory"); \
      _Pragma("unroll") for(int d_=0;d_<2;++d_) _Pragma("unroll") for(int r=0;r<16;++r)o[d_][r]*=wsf[crow(r,hi)]; } }while(0)
  f32x16 pA0,pA1,pB0,pB1;
  int sl_prev=0,sl_cur=0,sl_next=SLOTB;
  #define ROT() do{sl_prev=sl_cur;sl_cur=sl_next;sl_next=(sl_next==(NSLOT-1)*SLOTB)?0:sl_next+SLOTB;}while(0)
  DMA_K(2,2*SLOTB);
  WAIT_BAR(3);
  qkt(pA0,pA1,Kbase,qr,negm,r32,hi);asm volatile("s_nop 15\n\ts_nop 7":"+v"(pA0),"+v"(pA1));CMASK(pA0,pA1,0);
  START(pA0,pA1);
  _Pragma("unroll") for(int r=0;r<16;++r)pA1[r]=__builtin_amdgcn_exp2f(pA1[r]);
  WAIT_BAR(0);
  DMA_K(3,0);DMA_V(1,SLOTB);
  ROT();
  kload8(kf,kp0+sl_cur);
  WAIT_BAR(2);
  s16x4 vlo[8],vhi[8]; u32x4 pw0,pw1,pw2,pw3;
  #define PKW(P,B) cvtpk_s(P[B],P[B+1])
  #define PAF(k) __builtin_bit_cast(bf16x8,pw##k)
  #define VFR(i) (bf16x8){vlo[i][0],vlo[i][1],vlo[i][2],vlo[i][3],vhi[i][0],vhi[i][1],vhi[i][2],vhi[i][3]}
  #define PIN(x) asm volatile("":"+v"(x))
  #define MX3(a,b,c) __builtin_fmaxf(__builtin_fmaxf((a),(b)),(c))
  #define GAPA(MF,A0,A1,A2,A3,W0,W1,PW) do{ MF; sacc+=A0; sacc+=A1; sacc+=A2; sacc+=A3; PIN(sacc); W0; W1; PIN(PW); SBAR(); }while(0)
  #define EX(v) __builtin_amdgcn_exp2f(v)
  #define GAPB(MF,X,B) do{ MF; X[B]=EX(X[B]); X[B+1]=EX(X[B+1]); X[B+2]=EX(X[B+2]); X[B+3]=EX(X[B+3]); PIN(X); SBAR(); }while(0)
  #define VRD(i) do{ vlo[i]=vtr(vp_+(((i)>>2)*4096+((i)&3)*1024)); vhi[i]=vtr(vp_+(((i)>>2)*4096+((i)&3)*1024+512)); }while(0)
  #define KRD(G,j) do{ if(G){ kload2(kf,kp0+sl_next,j); SBAR(); } }while(0)
  #define STEP(C0,C1,P0,P1,t,GK,GV,GL) do{ SBAR(); \
    const lds_cptr vp_=vp0+sl_prev; \
    VRD(0); SBAR(); float sacc=(P0[0]+P0[1]); \
    GAPA(C0=__builtin_amdgcn_mfma_f32_32x32x16_bf16(kf[0],qr[0],negm,0,0,0), P0[2],P0[3],P0[4],P0[5],     pw0[0]=PKW(P0,0), pw0[1]=PKW(P0,2), pw0); \
    VRD(4); SBAR(); GAPA(C1=__builtin_amdgcn_mfma_f32_32x32x16_bf16(kf[1],qr[0],negm,0,0,0), P0[6],P0[7],P0[8],P0[9],     pw0[2]=PKW(P0,4), pw0[3]=PKW(P0,6), pw0); \
    VRD(1); SBAR(); GAPA(C0=__builtin_amdgcn_mfma_f32_32x32x16_bf16(kf[2],qr[1],C0,0,0,0),   P0[10],P0[11],P0[12],P0[13], pw1[0]=PKW(P0,8), pw1[1]=PKW(P0,10), pw1); \
    VRD(5); SBAR(); GAPA(C1=__builtin_amdgcn_mfma_f32_32x32x16_bf16(kf[3],qr[1],C1,0,0,0),   P0[14],P0[15],P1[0],P1[1],   pw1[2]=PKW(P0,12),pw1[3]=PKW(P0,14), pw1); \
    VRD(2); SBAR(); GAPA(C0=__builtin_amdgcn_mfma_f32_32x32x16_bf16(kf[4],qr[2],C0,0,0,0),   P1[2],P1[3],P1[4],P1[5],     pw2[0]=PKW(P1,0), pw2[1]=PKW(P1,2), pw2); \
    VRD(6); SBAR(); GAPA(C1=__builtin_amdgcn_mfma_f32_32x32x16_bf16(kf[5],qr[2],C1,0,0,0),   P1[6],P1[7],P1[8],P1[9],     pw2[2]=PKW(P1,4), pw2[3]=PKW(P1,6), pw2); \
    VRD(3); SBAR(); GAPA(C0=__builtin_amdgcn_mfma_f32_32x32x16_bf16(kf[6],qr[3],C0,0,0,0),   P1[10],P1[11],P1[12],P1[13], pw3[0]=PKW(P1,8), pw3[1]=PKW(P1,10), pw3); \
    VRD(7); SBAR(); GAPA(C1=__builtin_amdgcn_mfma_f32_32x32x16_bf16(kf[7],qr[3],C1,0,0,0),   P1[14],P1[15],0.f,0.f,       pw3[2]=PKW(P1,12),pw3[3]=PKW(P1,14), pw3); \
    l_reg+=sacc; \
    if(GK){DMA_K((t)+3,sl_cur);} if(GV){DMA_V((t)+1,sl_next);} \
    CMASK(C0,C1,t); \
    { float a=MX3(C0[0],C0[1],C1[0]),b=MX3(C0[2],C0[3],C1[1]); a=MX3(a,C1[2],C1[3]); \
      _Pragma("unroll") for(int r=4;r<16;r+=4){a=MX3(a,C0[r],C0[r+1]);b=MX3(b,C0[r+2],C0[r+3]);a=MX3(a,C1[r],C1[r+1]);b=MX3(b,C1[r+2],C1[r+3]);} \
      float rm=__builtin_fmaxf(a,b); { auto rr=__builtin_amdgcn_permlane32_swap(__float_as_uint(rm),__float_as_uint(rm),false,false); rm=__builtin_fmaxf(__uint_as_float(rr[0]),__uint_as_float(rr[1])); } \
      resc=false; \
      if(__builtin_expect(__any(rm>(float)THRL),0)){ const float dl=__builtin_fmaxf(rm,0.f); mhat+=dl; \
        _Pragma("unroll") for(int r=0;r<16;++r){C0[r]-=dl;C1[r]-=dl;} \
        _Pragma("unroll") for(int r=0;r<16;++r)negm[r]=-mhat; asm volatile("":"+v"(negm)); \
        const float f=__builtin_amdgcn_exp2f(-dl); l_reg*=f; if(hi==0)wsf[r32]=f; resc=true; } } \
    SBAR(); \
    GAPB(o[0]=__builtin_amdgcn_mfma_f32_32x32x16_bf16(PAF(0),VFR(0),o[0],0,0,0), C0,0); \
    GAPB(o[1]=__builtin_amdgcn_mfma_f32_32x32x16_bf16(PAF(0),VFR(4),o[1],0,0,0), C0,4); \
    KRD(GL,0); GAPB(o[0]=__builtin_amdgcn_mfma_f32_32x32x16_bf16(PAF(1),VFR(1),o[0],0,0,0), C0,8); \
    KRD(GL,1); GAPB(o[1]=__builtin_amdgcn_mfma_f32_32x32x16_bf16(PAF(1),VFR(5),o[1],0,0,0), C0,12); \
    KRD(GL,2); GAPB(o[0]=__builtin_amdgcn_mfma_f32_32x32x16_bf16(PAF(2),VFR(2),o[0],0,0,0), C1,0); \
    KRD(GL,3); GAPB(o[1]=__builtin_amdgcn_mfma_f32_32x32x16_bf16(PAF(2),VFR(6),o[1],0,0,0), C1,4); \
    GAPB(o[0]=__builtin_amdgcn_mfma_f32_32x32x16_bf16(PAF(3),VFR(3),o[0],0,0,0), C1,8); \
    GAPB(o[1]=__builtin_amdgcn_mfma_f32_32x32x16_bf16(PAF(3),VFR(7),o[1],0,0,0), C1,12); \
    }while(0)
  int t=1;
  for(;t+5<NT;t+=2){
    STEP(pB0,pB1,pA0,pA1,t,true,true,true);     WAIT_BAR(2); RESC(); ROT();
    STEP(pA0,pA1,pB0,pB1,t+1,true,true,true);   WAIT_BAR(2); RESC(); ROT();
  }
  #define ENDW(tt) do{ if((tt)+3<NT){WAIT_BAR(2);} else if((tt)+2<NT){WAIT_BAR(1);} else {WAIT_BAR(0);} }while(0)
  for(;t+1<NT;t+=2){
    STEP(pB0,pB1,pA0,pA1,t,(t+3<NT),(t+1<NT),(t+1<NT));       ENDW(t);   RESC(); ROT();
    STEP(pA0,pA1,pB0,pB1,t+1,(t+4<NT),(t+2<NT),(t+2<NT));     ENDW(t+1); RESC(); ROT();
  }
  STEP(pB0,pB1,pA0,pA1,NT-1,false,false,false); RESC();
  { float sacc=pB0[0]+pB0[1]; _Pragma("unroll") for(int r=2;r<16;++r)sacc+=pB0[r]; _Pragma("unroll") for(int r=0;r<16;++r)sacc+=pB1[r]; l_reg+=sacc;
    pw0=(u32x4){PKW(pB0,0),PKW(pB0,2),PKW(pB0,4),PKW(pB0,6)};pw1=(u32x4){PKW(pB0,8),PKW(pB0,10),PKW(pB0,12),PKW(pB0,14)};pw2=(u32x4){PKW(pB1,0),PKW(pB1,2),PKW(pB1,4),PKW(pB1,6)};pw3=(u32x4){PKW(pB1,8),PKW(pB1,10),PKW(pB1,12),PKW(pB1,14)};
    SBAR(); pv(o,vb0+sl_cur,PAF(0),PAF(1),PAF(2),PAF(3)); }
  #undef PKW
  #undef PAF
  #undef VFR
  #undef PIN
  #undef MX3
  #undef GAPA
  #undef GAPB
  #undef EX
  #undef VRD
  #undef KRD
  #undef STEP
  #undef ENDW
  {auto rr=__builtin_amdgcn_permlane32_swap(__float_as_uint(l_reg),__float_as_uint(l_reg),false,false);l_reg=__uint_as_float(rr[0])+__uint_as_float(rr[1]);}
  if(hi==0)wsf[32+r32]=l_reg;asm volatile("s_waitcnt lgkmcnt(0)":::"memory");
  float rli[16];
  #pragma unroll
  for(int r=0;r<16;++r)rli[r]=__builtin_amdgcn_rcpf(wsf[32+crow(r,hi)]);
  bf16*Ow=O+(rowbase+q0+wid*QBLK)*DMO+h*D;
  { bf16*stg=(bf16*)(shm+LDS_OST)+wid*2048;
    #pragma unroll
    for(int r=0;r<16;++r){const int orow=crow(r,hi);
      #pragma unroll
      for(int d0=0;d0<2;++d0)stg[orow*64+d0*32+r32]=__float2bfloat16(o[d0][r]*rli[r]);}
    asm volatile("s_waitcnt lgkmcnt(0)":::"memory");
    #pragma unroll
    for(int i=0;i<4;++i){const int row=i*8+(lane>>3),ch=lane&7; const u32x4 v=*(const u32x4*)(stg+row*64+ch*8); ATTN_STORE16(Ow+(long)row*DMO+ch*8,v);} }
  asm volatile("s_waitcnt lgkmcnt(0)\n\ts_barrier":::"memory");
  #undef DMA_K
  #undef AT
  #undef DMA_V
  #undef CMASK
  #undef START
  #undef RESC
  #undef ROT
}
constexpr int ATTN_LDS_BYTES=LDS_BYTES;
struct AttnTensors { const bf16* Q; const bf16* K; const bf16* V; bf16* O; const float* KM; };
struct AttnUnit { int bh; int qb; };
struct StaticOrder {
  int vcu;
  __device__ __forceinline__ explicit StaticOrder(int grid,int block):vcu((block%8)*(grid/8)+block/8){}
  __device__ __forceinline__ bool next(int i,AttnUnit&u)const{ if(i>=2)return false; const int s=vcu&7; u.bh=vcu>>3; u.qb=(i==0)?15-s:s; return true; }
  __device__ __forceinline__ void a_ready(const AttnUnit&)const{}
  __device__ __forceinline__ void done(const AttnUnit&)const{}
};
template<class Sched,int THRL=8> __device__ __forceinline__ void attn_phase(char*lds,const AttnTensors&T,const Sched&S,int tid_wave){
  AttnUnit u;
  for(int i=0;S.next(i,u);++i){ int l_; asm volatile("v_mbcnt_lo_u32_b32 %0, -1, 0\n\tv_mbcnt_hi_u32_b32 %0, -1, %0":"=v"(l_)); const int t_=tid_wave*64+l_;
    S.a_ready(u); attn_unit<THRL>(u.bh/NHEAD,u.bh%NHEAD,u.qb,T.Q,T.K,T.V,T.O,T.KM,lds,t_); S.done(u); }
}
#undef SBAR
#undef WAIT_BAR
}
namespace {
#define XB_TMO      128
#define XB_XCNT(j)  (256  + 64 * (j))
#define XB_XSUB(j)  (1280 + 64 * (j))
#define XB_XGEN(j)  (2304 + 64 * (j))
#define XB_TOP      3328
#define XB_TOPGEN   3392
#define XCD_BAR_WORDS 3456
#define XB_SPIN_CAP (1u << 18)

__device__ __forceinline__ unsigned xb_ld(unsigned* p)              { return __hip_atomic_load(p, __ATOMIC_RELAXED, __HIP_MEMORY_SCOPE_AGENT); }
__device__ __forceinline__ unsigned xb_add(unsigned* p, unsigned v) { return __hip_atomic_fetch_add(p, v, __ATOMIC_RELAXED, __HIP_MEMORY_SCOPE_AGENT); }
__device__ __forceinline__ unsigned xb_xcc_id() { return (unsigned)__builtin_amdgcn_s_getreg((3 << 11) | 20) & 0xFu; }
#define XB_SPIN(cond, bar) do { unsigned _sp = 0; while (cond) { __builtin_amdgcn_s_sleep(1); \
    if ((++_sp & 255u) == 0u) { if (xb_ld(&(bar)[XB_TMO])) break; if (_sp > XB_SPIN_CAP) { atomicAdd(&(bar)[XB_TMO], 1u); break; } } } } while (0)

struct XcdBarrier {
    unsigned* bar; unsigned x;
    volatile LAS unsigned* st;
};

__device__ __forceinline__ XcdBarrier xcd_barrier_post(unsigned* bar, volatile LAS unsigned* st, int tid) {
    XcdBarrier b; b.bar = bar; b.x = xb_xcc_id(); b.st = st;
    if (tid == 0) (void)xb_add(&bar[XB_XCNT(b.x)], 1u);
    return b;
}
__device__ __forceinline__ void xcd_barrier_complete(unsigned* bar, unsigned x, unsigned& nloc, unsigned& nx) {
    const unsigned G = GRID;
    unsigned sum, cnt, mine, sp = 0u;
    for (;;) {
        sum = 0u; cnt = 0u; mine = 0u;
#pragma unroll
        for (unsigned j = 0; j < 16; ++j) { const unsigned c = xb_ld(&bar[XB_XCNT(j)]); sum += c; cnt += (c > 0u) ? 1u : 0u; mine = (j == x) ? c : mine; }
        if (sum == G) break;
        __builtin_amdgcn_s_sleep(1);
        if ((++sp & 255u) == 0u) { if (xb_ld(&bar[XB_TMO])) break; if (sp > XB_SPIN_CAP) { atomicAdd(&bar[XB_TMO], 1u); break; } }
    }
    nloc = mine > 0u ? mine : 1u; nx = cnt > 0u ? cnt : 1u;
}

__device__ __forceinline__ void xcd_barrier(const XcdBarrier& b, int tid) {
    asm volatile("s_waitcnt vmcnt(0)" ::: "memory");
    __syncthreads();
    if (tid == 0) {
        unsigned* bar = b.bar;
        __builtin_amdgcn_s_waitcnt(0);
        unsigned nloc = b.st[0], nx = b.st[1];
        if (nloc == 0u) { xcd_barrier_complete(bar, b.x, nloc, nx); b.st[0] = nloc; b.st[1] = nx; }
        const unsigned old = xb_add(&bar[XB_XSUB(b.x)], 1u);
        const unsigned gen = old / nloc;
        if (old + 1u == (gen + 1u) * nloc) {
            __builtin_amdgcn_fence(__ATOMIC_RELEASE, "agent");
            asm volatile("s_waitcnt vmcnt(0)" ::: "memory");
            const unsigned og = xb_add(&bar[XB_TOP], 1u);
            const unsigned tg = og / nx;
            if (og + 1u == (tg + 1u) * nx) xb_add(&bar[XB_TOPGEN], 1u);
            else XB_SPIN(xb_ld(&bar[XB_TOPGEN]) == tg, bar);
            __builtin_amdgcn_fence(__ATOMIC_ACQUIRE, "agent");
            xb_add(&bar[XB_XGEN(b.x)], 1u);
            asm volatile("s_waitcnt vmcnt(0)" ::: "memory");
        } else {
            XB_SPIN(xb_ld(&bar[XB_XGEN(b.x)]) == gen, bar);
            __builtin_amdgcn_fence(__ATOMIC_ACQUIRE, "agent");
            asm volatile("s_waitcnt vmcnt(0)" ::: "memory");
        }
    }
    __syncthreads();
}
}
#ifndef GEMM_ALIGN
#define GEMM_ALIGN true
#endif
#ifndef GEMM_SP2
#define GEMM_SP2 true
#endif
#ifndef FAST_ATTN
#define FAST_ATTN 1
#endif

namespace {
constexpr int NPHASES = 2 + 9 * DEPTH;
__global__ void __launch_bounds__(NTHREADS, 2) fwd(Args args) {
    extern __shared__ __attribute__((aligned(16))) unsigned char lds_raw[];
    Frame F;
    F.lds = (LAS unsigned char*)lds_raw;
    F.wave = __builtin_amdgcn_readfirstlane(threadIdx.x >> 6);
    F.G = GRID; { const int bx = blockIdx.x; F.vcu = (bx % 8) * (GRID / 8) + bx / 8; }
    volatile LAS unsigned* MISC = (volatile LAS unsigned*)(F.lds + LDS_BYTES - 128);
    { int l0_; asm volatile("v_mbcnt_lo_u32_b32 %0, -1, 0\n\tv_mbcnt_hi_u32_b32 %0, -1, %0" : "=v"(l0_)); if (F.wave == 0 && l0_ < 32) MISC[l0_] = 0u; }
    __syncthreads();
    XcdBarrier bar;
    { int l0_; asm volatile("v_mbcnt_lo_u32_b32 %0, -1, 0\n\tv_mbcnt_hi_u32_b32 %0, -1, %0" : "=v"(l0_));
      bar = xcd_barrier_post((unsigned*)(args.ws + WS_CTL) + 4096, MISC + 8, F.wave * 64 + l0_); }
    if (args.ph_lo < 0) cooperative_groups::this_grid().sync();
    for (int ph = args.ph_lo; ph < args.ph_hi; ++ph) {
#ifndef PROBE_DUP
#define PROBE_DUP(ph) 0
#endif
      for (int rep_ = 0; rep_ < (PROBE_DUP(ph) ? 2 : 1); ++rep_) {
        if (ph > args.ph_lo || rep_ > 0) { int l0_; asm volatile("v_mbcnt_lo_u32_b32 %0, -1, 0\n\tv_mbcnt_hi_u32_b32 %0, -1, %0" : "=v"(l0_)); xcd_barrier(bar, F.wave * 64 + l0_);
#ifdef PROBE_BAR2
          xcd_barrier(bar, F.wave * 64 + l0_);
#endif
        }
#ifdef PROBE_EPI
        if (ph == PROBE_TS && blockIdx.x == 0 && F.wave == 0) { volatile LAS unsigned long long* ep_ = (volatile LAS unsigned long long*)(F.lds + LDS_BYTES - 640); ep_[0] = 0ull; }
        if (ph == PROBE_TS + 1 && blockIdx.x == 0 && F.wave == 0) { volatile LAS unsigned long long* ep_ = (volatile LAS unsigned long long*)(F.lds + LDS_BYTES - 640); ep_[1] = ep_[0]; }
#endif
#ifdef PROBE_TS
        if (rep_ == 0 && blockIdx.x == 0 && F.wave == 0) { volatile LAS unsigned long long* tsl = (volatile LAS unsigned long long*)(F.lds + LDS_BYTES - 512); tsl[ph] = __builtin_amdgcn_s_memrealtime(); }
#endif
        ArgsP ap = (ArgsP)__builtin_amdgcn_kernarg_segment_ptr(); asm volatile("" : "+s"(ap));
        unsigned char* ws = ap->ws; F.ws = ws;
#define FRESH_TID() do { int l_; asm volatile("v_mbcnt_lo_u32_b32 %0, -1, 0\n\tv_mbcnt_hi_u32_b32 %0, -1, %0" : "=v"(l_)); const int t_ = F.wave * 64 + l_; F.tid = t_; F.lane = l_; } while (0)
#ifndef EN_MASK
#define EN_MASK 63
#endif
        if (ph == 0) { FRESH_TID(); if (EN_MASK & 1) p0a(F, ap); continue; }
        if (ph == 1) { FRESH_TID(); if (EN_MASK & 2) p0b(F, ap, rep_ == 0); continue; }
        const int l = (ph - 2) / 9, sub = (ph - 2) % 9;
        const unsigned char* wl = ws + WS_W + (size_t)l * W_LAYER;
        const float* xin0 = (l == 0) ? (const float*)ap->in[0] : (const float*)ap->out;
        if ((EN_MASK & 4) && (sub == 0 || sub == 7)) {
            FRESH_TID();
            const int st = 3 * l + (sub == 0 ? 0 : 2);
            pg8::Gemm g{(const pg8::bf16_t*)(ws + WS_XS), (const pg8::bf16_t*)(wl + (sub == 0 ? W_F1IN : W_F2IN)), M, 2 * DFF, D};
            pg8::StaticOrder So; So.init(M, 2 * DFF, GRID, (int)blockIdx.x);
            pg8::EpiSwiGLU E{ws, st, l * SWL + (sub == 0 ? SW_F1 : SW_F2)};
            pg8::gemm_phase<pg8::EpiSwiGLU, pg8::StaticOrder, GEMM_ALIGN, GEMM_SP2>(F.lds, g, So, E, F.tid);
            if (blockIdx.x >= 128 && !(l == 1 && sub == 7)) { const int rank = ((int)blockIdx.x - 128) * NWAVES + F.wave;
                if (l == 0 && sub == 0) tr_range(F, ap, TR_S1, TR_S2, rank, 128 * NWAVES, true);
                else if (l == 0) tr_range(F, ap, TR_S2, TR_S3, rank, 128 * NWAVES, true);
                else tr_range(F, ap, TR_S3, DEPTH * IT_LAYER, rank, 128 * NWAVES, true); }
        } else if ((EN_MASK & 8) && (sub == 1 || sub == 8)) {
            FRESH_TID();
            const int nst = 3 * l + (sub == 1 ? 1 : 3);
            pg8::Gemm g{(const pg8::bf16_t*)(ws + WS_HMID), (const pg8::bf16_t*)(wl + (sub == 1 ? W_F1OUT : W_F2OUT)), M, D, DFF};
            pg8::StaticOrder So; So.init(M, D, GRID, (int)blockIdx.x);
            pg8::EpiResid E{(sub == 1) ? xin0 : (const float*)ap->out, ap->out, ws, l * NB * MODW + (sub == 1 ? 2 : 8) * D, 0.5f, (nst < 6) ? nst : -1};
            pg8::gemm_phase<pg8::EpiResid, pg8::StaticOrder, GEMM_ALIGN, GEMM_SP2>(F.lds, g, So, E, F.tid);
        } else if ((EN_MASK & 16) && sub == 2) {
            FRESH_TID();
            pg8::Gemm g{(const pg8::bf16_t*)(ws + WS_XS), (const pg8::bf16_t*)(wl + W_MIXIN), M, 3072, D};
            pg8::StaticOrder So; So.init(M, 3072, GRID, (int)blockIdx.x);
            pg8::EpiMixIn E{ws, (const float*)ap->in[10] + l * 64, (const float*)ap->in[11] + l * 64, l, QSCALE};
            pg8::gemm_phase<pg8::EpiMixIn, pg8::StaticOrder, GEMM_ALIGN, GEMM_SP2>(F.lds, g, So, E, F.tid);
        } else if (sub == 3) {
            FRESH_TID();
#ifndef PROBE_LOCAL_REP
#define PROBE_LOCAL_REP 1
#endif
#ifndef PROBE_CONV_REP
#define PROBE_CONV_REP 1
#endif
            for (int u = F.vcu; u < 512; u += GRID) { if (u < 256) { for (int q_ = 0; q_ < PROBE_LOCAL_REP; ++q_) gla_local_unit(F, ap, l, u); } else { for (int q_ = 0; q_ < PROBE_CONV_REP; ++q_) conv_unit(F, ap, l, u - 256); } }
        } else if (sub == 4) {
            FRESH_TID();
            for (int u = F.vcu; u < 128; u += GRID) gla_scan_unit(F, u);
#ifndef FAST_ATTN
#define FAST_ATTN 1
#endif
#if FAST_ATTN
            { const attn_body::AttnTensors AT{(const attn_body::bf16*)(ws + WS_QB), (const attn_body::bf16*)(ws + WS_KB), (const attn_body::bf16*)(ws + WS_VB), (attn_body::bf16*)(ws + WS_CONCAT), (const float*)(ws + WS_KMEAN) + (size_t)l * 32768};
              const attn_body::StaticOrder So(GRID, (int)blockIdx.x);
              __syncthreads();
              attn_body::attn_phase<attn_body::StaticOrder>((char*)lds_raw, AT, So, F.wave); }
#endif
        } else if (sub == 5) {
            FRESH_TID();
#ifndef PROBE_OUT_REP
#define PROBE_OUT_REP 1
#endif
            for (int u = F.vcu; u < 256; u += GRID) for (int q_ = 0; q_ < PROBE_OUT_REP; ++q_) gla_out_unit(F, ap, l, u);
        } else if ((EN_MASK & 32) && sub == 6) {
            FRESH_TID();
            const int nst = 3 * l + 2;
            pg8::Gemm g{(const pg8::bf16_t*)(ws + WS_CONCAT), (const pg8::bf16_t*)(wl + W_MIXOUT), M, D, D};
            pg8::StaticOrder So; So.init(M, D, GRID, (int)blockIdx.x);
            pg8::EpiResid E{(const float*)ap->out, ap->out, ws, l * NB * MODW + 5 * D, 1.0f, nst};
            pg8::gemm_phase<pg8::EpiResid, pg8::StaticOrder, GEMM_ALIGN, GEMM_SP2>(F.lds, g, So, E, F.tid);
        }
      }
    }
#ifdef PROBE_TS
    { int l0_; asm volatile("v_mbcnt_lo_u32_b32 %0, -1, 0\n\tv_mbcnt_hi_u32_b32 %0, -1, %0" : "=v"(l0_)); xcd_barrier(bar, F.wave * 64 + l0_);
      if (blockIdx.x == 0 && F.wave == 0 && l0_ == 0) { volatile LAS unsigned long long* tsl = (volatile LAS unsigned long long*)(F.lds + LDS_BYTES - 512);
        const unsigned long long tend = __builtin_amdgcn_s_memrealtime();
#ifdef PROBE_TS_TOTAL
        const unsigned long long t0 = tsl[0] * 10 / 10, t1 = t0 + (tend - tsl[0]) / 10;
#else
        const unsigned long long t0 = tsl[PROBE_TS], t1 = (PROBE_TS + 1 < NPHASES) ? tsl[PROBE_TS + 1] : tend;
#endif
#ifdef PROBE_EPI
        { volatile LAS unsigned long long* ep_ = (volatile LAS unsigned long long*)(F.lds + LDS_BYTES - 640); args.out[0] += (float)ep_[1] * 0.0001f; }
#else
        args.out[0] += (float)(t1 - t0) * 0.0001f;
#endif
        } }
#endif
}

__global__ void norm_xs_kernel(const float* x, const float* gp, bf16* XS, float* rowss) {
    const int row = blockIdx.x * 4 + (threadIdx.x >> 6), lane = threadIdx.x & 63, b = row / S;
    float ss = 0.f;
    for (int j = 0; j < 16; ++j) { const int c = lane + 64 * j; const float v = x[(size_t)row * D + c]; ss += v * v; XS[(size_t)row * D + c] = (bf16)f2bf(v * gp[b * D + c]); }
    ss = wave_sum(ss); if (lane == 0) rowss[row] = ss;
}
__global__ void norm_mod_kernel(const float* x, const float* gain, const float* shift, const float* scale, bf16* h) {
    const int row = blockIdx.x * 4 + (threadIdx.x >> 6), lane = threadIdx.x & 63, b = row / S;
    const float* xr = x + (size_t)row * D;
    float v[16], ss = 0.f;
#pragma unroll
    for (int j = 0; j < 16; ++j) { v[j] = xr[lane + 64 * j]; ss += v[j] * v[j]; }
    ss = wave_sum(ss);
    const float r = rsqrtf(ss / D + EPS);
#pragma unroll
    for (int j = 0; j < 16; ++j) { const int c = lane + 64 * j; h[(size_t)row * D + c] = (bf16)f2bf(v[j] * r * gain[c] * (1.f + scale[b * MODW + c]) + shift[b * MODW + c]); }
}
struct ProjDst { bf16 *QB, *KB, *VB, *BU, *CQ, *CK, *CV, *CR; float* CG; };
template <int EPI>
__global__ void gemm_kernel(const bf16* A, const float* B, float* C, int N, int K, int ldb, const float* gate, float coef, ProjDst pd) {
    __shared__ float As[16][65];
    __shared__ float Bs[16][64];
    const int tid = threadIdx.x, tx = tid & 15, ty = tid >> 4;
    const int m0 = blockIdx.y * 64, n0 = blockIdx.x * 64;
    float acc[4][4] = {};
    for (int k0 = 0; k0 < K; k0 += 16) {
#pragma unroll
        for (int i = 0; i < 4; ++i) { const int e = tid + 256 * i, r = e >> 4, kk = e & 15; As[kk][r] = bf2f(A[(size_t)(m0 + r) * K + k0 + kk]); }
#pragma unroll
        for (int i = 0; i < 4; ++i) { const int e = tid + 256 * i, kk = e >> 6, cc = e & 63; const int n = n0 + cc; Bs[kk][cc] = (n < N) ? B[(size_t)(k0 + kk) * ldb + n] : 0.f; }
        __syncthreads();
#pragma unroll
        for (int kk = 0; kk < 16; ++kk) {
            float a[4], bb[4];
#pragma unroll
            for (int i = 0; i < 4; ++i) { a[i] = As[kk][ty * 4 + i]; bb[i] = Bs[kk][tx * 4 + i]; }
#pragma unroll
            for (int i = 0; i < 4; ++i)
#pragma unroll
                for (int j = 0; j < 4; ++j) acc[i][j] += a[i] * bb[j];
        }
        __syncthreads();
    }
#pragma unroll
    for (int i = 0; i < 4; ++i)
#pragma unroll
        for (int j = 0; j < 4; ++j) { const int m = m0 + ty * 4 + i, n = n0 + tx * 4 + j; if (n >= N) continue; const float v = acc[i][j];
            if (EPI == 2) { const int b = m / S; C[(size_t)m * D + n] += coef * gate[b * MODW + n] * v; }
            else {
                if (n < 512) pd.QB[(size_t)m * 512 + n] = (bf16)f2bf(v);
                else if (n < 1024) pd.KB[(size_t)m * 512 + n - 512] = (bf16)f2bf(v);
                else if (n < 1536) pd.VB[(size_t)m * 512 + n - 1024] = (bf16)f2bf(v);
                else if (n < 2048) pd.BU[(size_t)m * 512 + n - 1536] = (bf16)f2bf(v);
                else if (n < 2304) pd.CQ[(size_t)m * 256 + n - 2048] = (bf16)f2bf(v);
                else if (n < 2560) pd.CK[(size_t)m * 256 + n - 2304] = (bf16)f2bf(v);
                else if (n < 2816) pd.CV[(size_t)m * 256 + n - 2560] = (bf16)f2bf(v);
                else if (n < 3072) pd.CR[(size_t)m * 256 + n - 2816] = (bf16)f2bf(v);
                else pd.CG[(size_t)m * 16 + n - 3072] = v;
            } }
}
__global__ void cg_kernel(const bf16* XS, const float* rowss, const bf16* wcg, const float* swcg, float* CG) {
    const int row = blockIdx.x * 4 + (threadIdx.x >> 6), lane = threadIdx.x & 63, b = row / S;
    float xv[16];
#pragma unroll
    for (int q = 0; q < 16; ++q) xv[q] = bf2f(XS[(size_t)row * D + 16 * lane + q]);
    const float r = rsqrtf(rowss[row] / D + EPS);
    for (int n = 0; n < 16; ++n) { float s = 0.f;
#pragma unroll
        for (int q = 0; q < 16; ++q) s += xv[q] * bf2f(wcg[(size_t)n * D + 16 * lane + q]);
        s = wave_sum(s); if (lane == 0) CG[(size_t)row * 16 + n] = r * s + swcg[b * 16 + n]; }
}
__global__ void glu_kernel(const bf16* BU, bf16* HGLU) {
    const int i = blockIdx.x * 256 + threadIdx.x; const int row = i >> 8, c = i & 255;
    HGLU[i] = (bf16)f2bf(bf2f(BU[(size_t)row * 512 + c]) * sigmoid_f(bf2f(BU[(size_t)row * 512 + 256 + c])));
}
__global__ void qk_prep_kernel(bf16* QB, bf16* KB, const int* positions, const float* qn, const float* kn) {
    const int gw = blockIdx.x * 4 + (threadIdx.x >> 6), lane = threadIdx.x & 63;
    const int row = gw >> 4, which = (gw >> 3) & 1, h = gw & 7;
    bf16* p = (which ? KB : QB) + (size_t)row * 512 + h * 64;
    const float v = bf2f(p[lane]);
    const float ss = wave_sum(v * v);
    const float y = v * rsqrtf(ss / 64.f + EPS) * (which ? kn[lane] : qn[lane]);
    const float yp = __shfl_xor(y, 32);
    const float ang = (float)positions[row] * INV_FREQ[lane & 31];
    const float cs = cosf(ang), sn = sinf(ang);
    const float o = (lane < 32) ? (y * cs - yp * sn) : (y * cs + yp * sn);
    p[lane] = (bf16)f2bf(which ? o : o * QSCALE);
}
__global__ void kmean_kernel(const bf16* KB, float* kmean) {
    const int idx = blockIdx.x * 256 + threadIdx.x;
    const int d = idx & 63, blk = (idx >> 6) & 15, h = (idx >> 10) & 7, b = idx >> 13;
    float s = 0.f;
    for (int r = 0; r < 256; ++r) s += bf2f(KB[(size_t)(b * S + blk * 256 + r) * 512 + h * 64 + d]);
    kmean[idx] = s / 256.f;
}
__global__ void attn_kernel(const bf16* QB, const bf16* KB, const bf16* VB, const float* kmean, bf16* concat) {
    const int gw = blockIdx.x * 4 + (threadIdx.x >> 6), lane = threadIdx.x & 63;
    const int h = gw & 7, row = gw >> 3, b = row / S, t = row % S, qb = t >> 8;
    const float qd = bf2f(QB[(size_t)row * 512 + h * 64 + lane]);
    int sel[3] = {-1, -1, -1};
    {
        float g[16];
#pragma unroll
        for (int n = 0; n < 16; ++n) { const float pr = qd * kmean[((b * 8 + h) * 16 + n) * 64 + lane]; g[n] = (n < qb) ? wave_sum(pr) : -1e30f; }
#pragma unroll
        for (int s3 = 0; s3 < 3; ++s3) { float best = -3e38f; int bi = -1;
#pragma unroll
            for (int n = 0; n < 16; ++n) { const bool taken = (n == sel[0]) || (n == sel[1]) || (n == sel[2]); if (!taken && g[n] > best) { best = g[n]; bi = n; } }
            sel[s3] = bi; }
    }
    int blks[4]; bool ok[4];
    blks[0] = qb; ok[0] = true;
#pragma unroll
    for (int s3 = 0; s3 < 3; ++s3) { ok[s3 + 1] = (sel[s3] >= 0) && (sel[s3] < qb); blks[s3 + 1] = ok[s3 + 1] ? sel[s3] : 0; }
    float sc[16];
    float mx = -3e38f;
#pragma unroll
    for (int s4 = 0; s4 < 4; ++s4)
#pragma unroll
        for (int r = 0; r < 4; ++r) {
            const int key = blks[s4] * 256 + r * 64 + lane;
            const bf16* kp = KB + (size_t)(b * S + key) * 512 + h * 64;
            float dot = 0.f;
            for (int d = 0; d < 64; ++d) dot += __shfl(qd, d) * bf2f(kp[d]);
            const bool valid = ok[s4] && (s4 > 0 || key <= t);
            sc[s4 * 4 + r] = valid ? dot : -3e38f;
            mx = fmaxf(mx, sc[s4 * 4 + r]);
        }
    mx = wave_max(mx);
    float sum = 0.f;
#pragma unroll
    for (int i = 0; i < 16; ++i) { sc[i] = (sc[i] > -1e38f) ? exp2f(sc[i] - mx) : 0.f; sum += sc[i]; }
    sum = wave_sum(sum);
    float o = 0.f;
#pragma unroll
    for (int s4 = 0; s4 < 4; ++s4)
#pragma unroll
        for (int r = 0; r < 4; ++r) {
            const bf16* vp = VB + (size_t)(b * S + blks[s4] * 256 + r * 64) * 512 + h * 64 + lane;
            for (int j = 0; j < 64; ++j) o += __shfl(sc[s4 * 4 + r], j) * bf2f(vp[(size_t)j * 512]);
        }
    concat[(size_t)row * D + h * 64 + lane] = (bf16)f2bf(o / sum);
}
__global__ void conv_kernel(const bf16* HGLU, const float* cw, const float* cb, const float* ng, const float* nb, bf16* concat) {
    const int gw = blockIdx.x * 4 + (threadIdx.x >> 6), lane = threadIdx.x & 63;
    const int g = gw & 3, row = gw >> 2, t = row % S, ch = g * 64 + lane;
    float acc = cb[ch];
    for (int j = 0; j < 31; ++j) { const int tt = t - 30 + j; if (tt < 0) continue; acc += cw[j * 256 + ch] * bf2f(HGLU[(size_t)(row - 30 + j) * 256 + ch]); }
    const float mu = wave_sum(acc) / 64.f;
    const float xc = acc - mu;
    const float var = wave_sum(xc * xc) / 64.f;
    const float y = xc * rsqrtf(var + EPS) * ng[ch] + nb[ch];
    concat[(size_t)row * D + 512 + ch] = (bf16)f2bf(silu_f(y));
}
__global__ void gla_kernel(const float* CG, const bf16* CQ, const bf16* CK, const bf16* CV, const float* gw_, const float* gb, float* graw) {
    const int gwv = blockIdx.x * 4 + (threadIdx.x >> 6), lane = threadIdx.x & 63;
    const int e = gwv & 63, h = (gwv >> 6) & 3, b = gwv >> 8;
    float wcol[16];
#pragma unroll
    for (int r = 0; r < 16; ++r) wcol[r] = gw_[r * 256 + h * 64 + lane];
    const float bias = gb[h * 64 + lane];
    float st = 0.f;
    for (int t = 0; t < S; ++t) {
        const size_t row = (size_t)b * S + t;
        float z = bias;
#pragma unroll
        for (int r = 0; r < 16; ++r) z += CG[row * 16 + r] * wcol[r];
        const float ls = fminf(z, 0.f) - log1pf(expf(-fabsf(z)));
        const float dec = expf(ls / 16.f);
        st = dec * st + bf2f(CK[row * 256 + h * 64 + lane]) * bf2f(CV[row * 256 + h * 64 + e]);
        const float o = wave_sum(bf2f(CQ[row * 256 + h * 64 + lane]) * 0.125f * st);
        if (lane == 0) graw[row * 256 + h * 64 + e] = o;
    }
}
__global__ void gla_post_kernel(const float* graw, const bf16* CR, const float* gn, bf16* concat) {
    const int gw = blockIdx.x * 4 + (threadIdx.x >> 6), lane = threadIdx.x & 63;
    const int h = gw & 3, row = gw >> 2;
    const float v = graw[(size_t)row * 256 + h * 64 + lane];
    const float ss = wave_sum(v * v);
    const float y = v * rsqrtf(ss / 64.f + EPS) * gn[lane];
    concat[(size_t)row * D + 768 + h * 64 + lane] = (bf16)f2bf(y * silu_f(bf2f(CR[(size_t)row * 256 + h * 64 + lane])));
}
}

#ifndef FAST_MIXIN
#define FAST_MIXIN 1
#endif
static void launch_fwd(Args a, int lo, int hi, hipStream_t stream) {
    a.ph_lo = lo; a.ph_hi = hi;
    hipLaunchKernelGGL(fwd, dim3(GRID), dim3(NTHREADS), LDS_BYTES, stream, a);
}
extern "C" void kernel_launch(void* const* d_in, const int* in_sizes, int n_in, void* d_out, int out_size, void* d_ws, size_t ws_size, hipStream_t stream) {
    static int ready = 0;
    if (!ready) {
        if (n_in != 23 || ws_size < WS_END || out_size != M * D) { fprintf(stderr, "kernel_launch: unexpected shapes (n_in %d ws %zu out %d)\n", n_in, ws_size, out_size); ready = -1; return; }
        if (hipFuncSetAttribute((const void*)fwd, hipFuncAttributeMaxDynamicSharedMemorySize, LDS_BYTES) != hipSuccess) { fprintf(stderr, "kernel_launch: hipFuncSetAttribute failed\n"); ready = -1; return; }
        { int dev = 0, cus = 0, per_cu = 0; (void)hipGetDevice(&dev); (void)hipDeviceGetAttribute(&cus, hipDeviceAttributeMultiprocessorCount, dev);
          (void)hipOccupancyMaxActiveBlocksPerMultiprocessor(&per_cu, (const void*)fwd, NTHREADS, LDS_BYTES);
          if (cus * per_cu < GRID) { fprintf(stderr, "kernel_launch: grid of %d workgroups is not co-resident (CUs %d x %d per CU)\n", GRID, cus, per_cu); ready = -1; return; } }
        ready = 1;
    }
    if (ready < 0) return;
    Args a{};
    for (int i = 0; i < 23; ++i) a.in[i] = d_in[i];
    a.out = (float*)d_out; a.ws = (unsigned char*)d_ws;
    unsigned char* ws = (unsigned char*)d_ws;
    (void)hipMemsetAsync(ws + WS_CTL, 0, CTL_ZERO_BYTES, stream);
#ifndef ONE_LAUNCH
#define ONE_LAUNCH 1
#endif
#if ONE_LAUNCH
    a.ph_lo = 0; a.ph_hi = NPHASES;
    { void* kargs[] = {&a};
#ifdef PROBE_PLAIN_LAUNCH
      hipLaunchKernelGGL(fwd, dim3(GRID), dim3(NTHREADS), LDS_BYTES, stream, a); hipError_t e = hipSuccess; (void)kargs;
#else
      hipError_t e = hipLaunchCooperativeKernel((const void*)fwd, dim3(GRID), dim3(NTHREADS), kargs, LDS_BYTES, stream);
#endif
      if (e != hipSuccess) fprintf(stderr, "kernel_launch: cooperative launch failed: %s\n", hipGetErrorString(e)); }
    return;
#endif
    launch_fwd(a, 0, 1, stream);
    launch_fwd(a, 1, 2, stream);
    float* X = (float*)d_out;
    const float* MOD = (const float*)(ws + WS_MOD); const float* GP = (const float*)(ws + WS_GP); float* ROWSS = (float*)(ws + WS_ROWSS);
    bf16* XS = (bf16*)(ws + WS_XS); bf16* CONCAT = (bf16*)(ws + WS_CONCAT);
    ProjDst pd{(bf16*)(ws + WS_QB), (bf16*)(ws + WS_KB), (bf16*)(ws + WS_VB), (bf16*)(ws + WS_KV), (bf16*)(ws + WS_CQ), (bf16*)(ws + WS_CK), (bf16*)(ws + WS_CV), (bf16*)(ws + WS_CR), (float*)(ws + WS_CG)};
    for (int l = 0; l < DEPTH; ++l) {
        const int base = 2 + 9 * l;
        const float* mod = MOD + (size_t)l * NB * MODW;
        launch_fwd(a, base + 0, base + 1, stream);
        launch_fwd(a, base + 1, base + 2, stream);
        float* KMEAN = (float*)(ws + WS_KMEAN) + (size_t)l * 32768;
#if FAST_MIXIN
        launch_fwd(a, base + 2, base + 3, stream);
        cg_kernel<<<M / 4, 256, 0, stream>>>(XS, ROWSS + (size_t)(3 * l + 1) * M, (const bf16*)(ws + WS_WCG) + (size_t)l * 16 * D, (const float*)(ws + WS_SW) + (size_t)l * SWL + SW_CG, pd.CG);
#else
        norm_mod_kernel<<<M / 4, 256, 0, stream>>>(X, (const float*)d_in[8] + l * D, mod + 3 * D, mod + 4 * D, XS);
        gemm_kernel<0><<<dim3((INW + 63) / 64, M / 64), 256, 0, stream>>>(XS, (const float*)d_in[9] + (size_t)l * D * INW, nullptr, INW, D, INW, nullptr, 0.f, pd);
        glu_kernel<<<M * 256 / 256, 256, 0, stream>>>(pd.BU, (bf16*)(ws + WS_HGLU));
        qk_prep_kernel<<<M * 16 / 4, 256, 0, stream>>>(pd.QB, pd.KB, (const int*)d_in[2], (const float*)d_in[10] + l * 64, (const float*)d_in[11] + l * 64);
        kmean_kernel<<<NB * 8 * 16 * 64 / 256, 256, 0, stream>>>(pd.KB, KMEAN);
#endif
#if !FAST_ATTN
        attn_kernel<<<M * 8 / 4, 256, 0, stream>>>(pd.QB, pd.KB, pd.VB, KMEAN, CONCAT);
#endif
#ifndef FAST_MIXERS
#define FAST_MIXERS 1
#endif
#if FAST_MIXERS
        launch_fwd(a, base + 3, base + 4, stream);
        launch_fwd(a, base + 4, base + 5, stream);
        launch_fwd(a, base + 5, base + 6, stream);
        launch_fwd(a, base + 6, base + 7, stream);
#else
        conv_kernel<<<M * 4 / 4, 256, 0, stream>>>((const bf16*)(ws + WS_HGLU), (const float*)d_in[12] + (size_t)l * 31 * 256, (const float*)d_in[13] + l * 256, (const float*)d_in[14] + l * 256, (const float*)d_in[15] + l * 256, CONCAT);
        gla_kernel<<<NB * 4 * 64 / 4, 256, 0, stream>>>(pd.CG, pd.CQ, pd.CK, pd.CV, (const float*)d_in[16] + (size_t)l * 16 * 256, (const float*)d_in[17] + l * 256, (float*)(ws + WS_KV));
        gla_post_kernel<<<M * 4 / 4, 256, 0, stream>>>((const float*)(ws + WS_KV), pd.CR, (const float*)d_in[18] + l * 64, CONCAT);
        gemm_kernel<2><<<dim3(D / 64, M / 64), 256, 0, stream>>>(CONCAT, (const float*)d_in[19] + (size_t)l * D * D, X, D, D, D, mod + 5 * D, 1.0f, pd);
        norm_xs_kernel<<<M / 4, 256, 0, stream>>>(X, GP + (size_t)(3 * l + 2) * NB * D, XS, ROWSS + (size_t)(3 * l + 2) * M);
#endif
        launch_fwd(a, base + 7, base + 8, stream);
        launch_fwd(a, base + 8, base + 9, stream);
    }
}
```
